# Optimizing an MI355X kernel written in HIP

```python
import math
import jax, jax.numpy as jnp
from jax import lax
import numpy as np

D_MODEL = 1024
BATCH = 8
SEQ = 2048
DEPTH = 2

D_FF = 2816
HALF_STEP = 0.5
N_MOD = 9
EPS = 1e-6

SB_HEADS = 4
SB_DIM = 64
SB_BLOCK = 128
SB_W = SB_HEADS * SB_DIM

GDN_HEADS = 4
GDN_DK = 128
GDN_DV = 128
GDN_CONV = 4
GDN_CHUNK = 64
GDN_WK = GDN_HEADS * GDN_DK
GDN_WV = GDN_HEADS * GDN_DV

HG_HEADS = 4
HG_DK = 64
HG_DV = 64
HG_CHUNK = 64
HG_WK = HG_HEADS * HG_DK
HG_WV = HG_HEADS * HG_DV

D_MIX = SB_W + GDN_WV + HG_WV
IN_SIZES = (SB_W, SB_W, SB_W, GDN_WK, GDN_WK, GDN_WV, GDN_WV, GDN_HEADS, GDN_HEADS,
            HG_WK, HG_WK, HG_WV, HG_WV)
D_IN = sum(IN_SIZES)
SPLITS = tuple(int(s) for s in np.cumsum(IN_SIZES)[:-1])

kernel_name = 'hybrid_sb_gdn_hgrn2_macaron_adaln'


def _rms_norm(x, gain):
    x32 = x.astype(jnp.float32)
    y = x32 * lax.rsqrt(jnp.mean(x32 * x32, axis=-1, keepdims=True) + EPS)
    return (y * gain.astype(jnp.float32)).astype(x.dtype)


def _l2_normalize(x):
    x32 = x.astype(jnp.float32)
    return x32 * lax.rsqrt(jnp.sum(x32 * x32, axis=-1, keepdims=True) + EPS)


def _modulate(h, shift, scale):
    return h * (1.0 + scale[:, None, :]) + shift[:, None, :]


def _swiglu(h, w_in, w_out):
    gate, up = jnp.split(h @ w_in, 2, axis=-1)
    return (jax.nn.silu(gate) * up) @ w_out


def _causal_depthwise_conv(x, w):
    return lax.conv_general_dilated(
        x, w[:, None, :].astype(x.dtype), window_strides=(1,),
        padding=((GDN_CONV - 1, 0),), dimension_numbers=('NWC', 'WIO', 'NWC'),
        feature_group_count=x.shape[-1])


def _to_chunks(x, chunk):
    b, t, h = x.shape[:3]
    x = x.reshape((b, t // chunk, chunk, h) + x.shape[3:])
    x = jnp.moveaxis(x, 3, 2)
    return jnp.moveaxis(x, 1, 0)


def _from_chunks(o):
    n, b, h, c, e = o.shape
    return o.transpose(1, 0, 3, 2, 4).reshape(b, n * c, h, e)


def _stick_breaking_attention(q, k, v):
    seq, d = q.shape[1], q.shape[3]
    q = q.transpose(0, 2, 1, 3).astype(jnp.float32)
    k = k.transpose(0, 2, 1, 3).astype(jnp.float32)
    v = v.transpose(0, 2, 1, 3).astype(jnp.float32)
    scale = d ** -0.5
    outs = []
    for blk in range(seq // SB_BLOCK):
        start = blk * SB_BLOCK
        end = start + SB_BLOCK
        qb = q[:, :, start:end]
        kb = k[:, :, :end]
        vb = v[:, :, :end]
        z = jnp.einsum('bhtd,bhsd->bhts', qb, kb) * scale
        t_idx = start + jnp.arange(SB_BLOCK)[:, None]
        s_idx = jnp.arange(end)[None, :]
        causal = s_idx < t_idx
        log_keep = jnp.where(causal, -jax.nn.softplus(z), 0.0)
        between = lax.cumsum(log_keep, axis=3, reverse=True) - log_keep
        log_w = jnp.where(causal, jax.nn.log_sigmoid(z) + between, -jnp.inf)
        outs.append(jnp.einsum('bhts,bhsd->bhtd', jnp.exp(log_w), vb))
    o = jnp.concatenate(outs, axis=2)
    return o.transpose(0, 2, 1, 3)


def _gated_delta_rule(q, k, v, log_a, beta):
    c = GDN_CHUNK
    dk, dv = q.shape[-1], v.shape[-1]
    q, k, v = (_to_chunks(t, c) for t in (q, k, v))
    log_a = _to_chunks(log_a, c)
    beta = _to_chunks(beta, c)
    g = jnp.cumsum(log_a, axis=-1)
    incl = jnp.tril(jnp.ones((c, c), dtype=bool))
    strict = jnp.tril(jnp.ones((c, c), dtype=bool), k=-1)
    decay = jnp.exp(jnp.where(incl, g[..., :, None] - g[..., None, :], -jnp.inf))
    k_beta = k * beta[..., None]
    a_kk = jnp.where(strict, jnp.einsum('nbhcd,nbhsd->nbhcs', k_beta, k) * decay, 0.0)
    eye = jnp.eye(c, dtype=jnp.float32)
    rhs = jnp.concatenate([v * beta[..., None], k_beta * jnp.exp(g)[..., None]], axis=-1)
    sol = lax.linalg.triangular_solve(eye + a_kk, rhs, left_side=True, lower=True,
                                      unit_diagonal=True)
    u, w = sol[..., :dv], sol[..., dv:]
    a_qk = jnp.einsum('nbhcd,nbhsd->nbhcs', q, k) * decay
    q_dec = q * jnp.exp(g)[..., None]
    k_dec = k * jnp.exp(g[..., -1:] - g)[..., None]
    chunk_decay = jnp.exp(g[..., -1])

    def step(state, xs):
        u_c, w_c, a_c, qd_c, kd_c, cd_c = xs
        v_new = u_c - jnp.einsum('bhcd,bhde->bhce', w_c, state)
        o = jnp.einsum('bhcd,bhde->bhce', qd_c, state) + jnp.einsum('bhcs,bhse->bhce', a_c, v_new)
        state = state * cd_c[..., None, None] + jnp.einsum('bhcd,bhce->bhde', kd_c, v_new)
        return state, o

    state0 = jnp.zeros(q.shape[1:3] + (dk, dv), jnp.float32)
    _, o = lax.scan(step, state0, (u, w, a_qk, q_dec, k_dec, chunk_decay))
    return _from_chunks(o)


def _hgrn2_recurrence(q, k, v, log_f):
    c = HG_CHUNK
    dk, dv = q.shape[-1], v.shape[-1]
    q, k, v, log_f = (_to_chunks(t, c) for t in (q, k, v, log_f))
    b = jnp.cumsum(log_f, axis=-2)
    incl = jnp.tril(jnp.ones((c, c), dtype=bool))[:, :, None]

    def step(state, xs):
        q_c, k_c, v_c, b_c = xs
        pair = jnp.exp(jnp.where(incl, b_c[..., :, None, :] - b_c[..., None, :, :], -jnp.inf))
        attn = jnp.einsum('bhtd,bhtsd,bhsd->bhts', q_c, pair, k_c)
        b_last = b_c[..., -1:, :]
        o = (jnp.einsum('bhtd,bhde->bhte', q_c * jnp.exp(b_c), state)
             + jnp.einsum('bhts,bhse->bhte', attn, v_c))
        state = (jnp.exp(b_last[..., 0, :])[..., None] * state
                 + jnp.einsum('bhsd,bhse->bhde', k_c * jnp.exp(b_last - b_c), v_c))
        return state, o

    state0 = jnp.zeros(q.shape[1:3] + (dk, dv), jnp.float32)
    _, o = lax.scan(step, state0, (q, k, v, b))
    return _from_chunks(o)


def _hybrid_mixer(h, w_in, conv_w, A_log, dt_bias, sb_gain, gdn_gain, hg_gain, lower_bound, w_out):
    bsz, seq, _ = h.shape
    f32 = jnp.float32
    proj = h @ w_in
    (sb_q, sb_k, sb_v, gd_q, gd_k, gd_v, gd_z, gd_b, gd_a,
     hg_q, hg_f, hg_i, hg_g) = jnp.split(proj, SPLITS, axis=-1)

    def heads(t, n):
        return t.reshape(bsz, seq, n, -1)

    o_sb = _stick_breaking_attention(heads(sb_q, SB_HEADS), heads(sb_k, SB_HEADS),
                                     heads(sb_v, SB_HEADS))
    o_sb = _rms_norm(o_sb, sb_gain).reshape(bsz, seq, SB_W)

    qkv = jax.nn.silu(_causal_depthwise_conv(jnp.concatenate([gd_q, gd_k, gd_v], axis=-1), conv_w))
    gq, gk, gv = jnp.split(qkv, [GDN_WK, 2 * GDN_WK], axis=-1)
    gq = _l2_normalize(heads(gq, GDN_HEADS)) * (GDN_DK ** -0.5)
    gk = _l2_normalize(heads(gk, GDN_HEADS))
    gv = heads(gv, GDN_HEADS).astype(f32)
    beta = jax.nn.sigmoid(gd_b.astype(f32))
    log_a = -jnp.exp(A_log.astype(f32)) * jax.nn.softplus(gd_a.astype(f32) + dt_bias.astype(f32))
    o_gd = _gated_delta_rule(gq, gk, gv, log_a, beta)
    o_gd = (_rms_norm(o_gd, gdn_gain) * jax.nn.silu(heads(gd_z, GDN_HEADS).astype(f32)))
    o_gd = o_gd.reshape(bsz, seq, GDN_WV)

    lb = lower_bound.astype(f32)
    f_pre = hg_f.astype(f32)
    log_f = jnp.logaddexp(jnp.log(lb), jnp.log1p(-lb) + jax.nn.log_sigmoid(f_pre))
    k_in = (1.0 - lb) * jax.nn.sigmoid(-f_pre)
    q_c = jax.nn.silu(hg_q.astype(f32))
    o_hg = _hgrn2_recurrence(heads(q_c, HG_HEADS), heads(k_in, HG_HEADS),
                             heads(hg_i.astype(f32), HG_HEADS), heads(log_f, HG_HEADS))
    o_hg = (_rms_norm(o_hg, hg_gain) * jax.nn.silu(heads(hg_g, HG_HEADS).astype(f32)))
    o_hg = o_hg.reshape(bsz, seq, HG_WV)

    o = jnp.concatenate([o_sb.astype(f32), o_gd, o_hg], axis=-1).astype(h.dtype)
    return o @ w_out


def setup_inputs(seed: int = 0) -> dict:
    key = jax.random.key(seed)
    ks = jax.random.split(key, 24)

    def nrm(k, shape, scale):
        return jax.random.normal(k, shape, jnp.float32) * scale

    def gain(k, shape):
        return 1.0 + nrm(k, shape, 0.02)

    dt = jnp.exp(jax.random.uniform(ks[10], (DEPTH, GDN_HEADS), jnp.float32,
                                    minval=math.log(1e-3), maxval=math.log(1e-1)))
    return {
        'x': nrm(ks[0], (BATCH, SEQ, D_MODEL), 1.0),
        'c': nrm(ks[1], (BATCH, D_MODEL), 1.0),
        'ffn1_norm': gain(ks[2], (DEPTH, D_MODEL)),
        'ffn1_w_in': nrm(ks[3], (DEPTH, D_MODEL, 2 * D_FF), D_MODEL ** -0.5),
        'ffn1_w_out': nrm(ks[4], (DEPTH, D_FF, D_MODEL), D_FF ** -0.5),
        'mix_norm': gain(ks[5], (DEPTH, D_MODEL)),
        'mix_w_in': nrm(ks[6], (DEPTH, D_MODEL, D_IN), D_MODEL ** -0.5),
        'gdn_conv_w': nrm(ks[7], (DEPTH, GDN_CONV, GDN_WK * 2 + GDN_WV), GDN_CONV ** -0.5),
        'gdn_A_log': jnp.log(jax.random.uniform(ks[8], (DEPTH, GDN_HEADS), jnp.float32,
                                                minval=1.0, maxval=16.0)),
        'gdn_dt_bias': dt + jnp.log(-jnp.expm1(-dt)),
        'sb_out_norm': gain(ks[11], (DEPTH, SB_DIM)),
        'gdn_out_norm': gain(ks[12], (DEPTH, GDN_DV)),
        'hg_out_norm': gain(ks[13], (DEPTH, HG_DV)),
        'hg_lb_logits': nrm(ks[14], (DEPTH, HG_WK), 0.1),
        'mix_w_out': nrm(ks[15], (DEPTH, D_MIX, D_MODEL), D_MIX ** -0.5),
        'ffn2_norm': gain(ks[16], (DEPTH, D_MODEL)),
        'ffn2_w_in': nrm(ks[17], (DEPTH, D_MODEL, 2 * D_FF), D_MODEL ** -0.5),
        'ffn2_w_out': nrm(ks[18], (DEPTH, D_FF, D_MODEL), D_FF ** -0.5),
        'ada_w': nrm(ks[19], (DEPTH, D_MODEL, N_MOD * D_MODEL), 0.5 * D_MODEL ** -0.5),
        'ada_b': nrm(ks[20], (DEPTH, N_MOD * D_MODEL), 0.01),
        'final_norm': gain(ks[21], (D_MODEL,)),
    }


def reference(x, c, ffn1_norm, ffn1_w_in, ffn1_w_out, mix_norm, mix_w_in, gdn_conv_w,
              gdn_A_log, gdn_dt_bias, sb_out_norm, gdn_out_norm, hg_out_norm, hg_lb_logits,
              mix_w_out, ffn2_norm, ffn2_w_in, ffn2_w_out, ada_w, ada_b, final_norm):
    lb_cum = jnp.cumsum(jax.nn.softmax(hg_lb_logits.astype(jnp.float32), axis=0), axis=0)
    lower_bounds = lb_cum - lb_cum[0:1]
    c_act = jax.nn.silu(c)
    bsz = x.shape[0]
    for layer in range(DEPTH):
        mod = (c_act @ ada_w[layer] + ada_b[layer]).reshape(bsz, N_MOD, D_MODEL)
        m = [mod[:, i] for i in range(N_MOD)]
        h = _modulate(_rms_norm(x, ffn1_norm[layer]), m[0], m[1])
        x = x + HALF_STEP * m[2][:, None, :] * _swiglu(h, ffn1_w_in[layer], ffn1_w_out[layer])
        h = _modulate(_rms_norm(x, mix_norm[layer]), m[3], m[4])
        y = _hybrid_mixer(h, mix_w_in[layer], gdn_conv_w[layer], gdn_A_log[layer],
                          gdn_dt_bias[layer], sb_out_norm[layer], gdn_out_norm[layer],
                          hg_out_norm[layer], lower_bounds[layer], mix_w_out[layer])
        x = x + m[5][:, None, :] * y
        h = _modulate(_rms_norm(x, ffn2_norm[layer]), m[6], m[7])
        x = x + HALF_STEP * m[8][:, None, :] * _swiglu(h, ffn2_w_in[layer], ffn2_w_out[layer])
    return _rms_norm(x, final_norm)
```

```cpp
#include <hip/hip_runtime.h>
#include <hip/hip_cooperative_groups.h>
#include <cstdio>
#include <cstdint>
namespace cg = cooperative_groups;
#ifndef PROBE
#define PROBE 0
#endif
__device__ __forceinline__ int tid_l() { int t = threadIdx.x; asm volatile("" : "+v"(t)); return t; }
namespace pg8 {
#define PG8_LAS __attribute__((address_space(3)))
typedef unsigned short bf16_t;
typedef short bf16x8 __attribute__((ext_vector_type(8)));
typedef float f32x4 __attribute__((ext_vector_type(4)));
typedef unsigned u32x4 __attribute__((ext_vector_type(4)));
constexpr int BM = 256, BK = 64, HALF = 128, HTB = HALF * BK * 2  , STAGE_BYTES = 8 * HTB, NXCD = 8, WGM = 8;

__host__ __device__ __forceinline__ int lds_byte(int r, int c) { const int st = (r >> 4) * 2 + (c >> 5), rr = r & 15, cc = c & 31, ob = rr * 64 + cc * 2; return st * 1024 + (ob ^ (((ob >> 9) & 1) << 5)); }
__host__ __device__ __forceinline__ void stage_rc(int b, int& R, int& C) { const int st = b / 1024, sb = b % 1024, swz = sb ^ (((sb >> 9) & 1) << 5); R = (st >> 1) * 16 + swz / 64; C = (st & 1) * 32 + (swz % 64) / 2; }
__host__ __device__ __forceinline__ int perm32(int rho) { const int n = rho >> 4, i = rho & 15; return 8 * (i >> 2) + 4 * n + (i & 3); }

struct Unit { int pm, pn; };
struct Gemm { const bf16_t* A; const bf16_t* Bt; int M, N, K; };

struct StaticOrder {
    int nM, nN, nwg, G, c;
    __host__ __device__ void init(int M, int N, int G_, int c_) { nM = M / BM; nN = N / BM; nwg = nM * nN; G = G_; c = c_; }
    __host__ __device__ bool next(int i, Unit& u) const {
        const long L = (long)i * G + c; if (L >= nwg) return false;
        int wgid = (int)L; { const int q = nwg / NXCD, r = nwg % NXCD, xcd = wgid % NXCD, off = wgid / NXCD; wgid = (xcd < r ? xcd * (q + 1) : r * (q + 1) + (xcd - r) * q) + off; }
        const int nig = WGM * nN, gid = wgid / nig, fm = gid * WGM, gsz = (nM - fm) < WGM ? (nM - fm) : WGM;
        u.pm = fm + ((wgid % nig) % gsz); u.pn = (wgid % nig) / gsz; return true;
    }
    __device__ __forceinline__ void a_ready(const Unit&) const {}
    __device__ __forceinline__ void done(const Unit&) const {}
};

typedef __bf16 bf16x2n_t __attribute__((ext_vector_type(2)));
typedef float f32x2n_t __attribute__((ext_vector_type(2)));
__device__ __forceinline__ unsigned cvt_pk_bf16(float lo, float hi) { const f32x2n_t v = {lo, hi}; return __builtin_bit_cast(unsigned, __builtin_convertvector(v, bf16x2n_t)); }
typedef float f32x2 __attribute__((ext_vector_type(2)));
__device__ __forceinline__ float silu_f(float g) { return g * __builtin_amdgcn_rcpf(1.0f + __expf(-g)); }
struct EpiBf16Plain {
    static constexpr bool PERM = true, AFTER_DRAIN = false;
    bf16_t* O; int ldc;
    __device__ __forceinline__ void operator()(const f32x4 (&acc)[2][2][4][2], const Unit& u, int wr, int wc, int fr, int fq) const {
        const int row0 = u.pm * BM + wr * 64 + fr, col0 = u.pn * BM + wc * 32 + 8 * fq;
#pragma unroll
        for (int ai = 0; ai < 2; ++ai)
#pragma unroll
            for (int m = 0; m < 4; ++m) { bf16_t* rowp = O + (size_t)(row0 + ai * HALF + m * 16) * ldc + col0;
#pragma unroll
                for (int bj = 0; bj < 2; ++bj) { const f32x4 v0 = acc[ai][bj][m][0], v1 = acc[ai][bj][m][1];
                    u32x4 w; w.x = cvt_pk_bf16(v0[0], v0[1]); w.y = cvt_pk_bf16(v0[2], v0[3]); w.z = cvt_pk_bf16(v1[0], v1[1]); w.w = cvt_pk_bf16(v1[2], v1[3]);
                    *(u32x4*)(rowp + bj * HALF) = w; } }
    }
};
struct EpiSwiglu {
    static constexpr bool PERM = true, AFTER_DRAIN = false;
    bf16_t* O; int ldc;
    __device__ __forceinline__ void operator()(const f32x4 (&acc)[2][2][4][2], const Unit& u, int wr, int wc, int fr, int fq) const {
        const int row0 = u.pm * BM + wr * 64 + fr, col0 = u.pn * HALF + wc * 32 + 8 * fq;
#pragma unroll
        for (int ai = 0; ai < 2; ++ai)
#pragma unroll
            for (int m = 0; m < 4; ++m) { bf16_t* rowp = O + (size_t)(row0 + ai * HALF + m * 16) * ldc + col0;
                const f32x4 g0 = acc[ai][0][m][0], g1 = acc[ai][0][m][1], u0 = acc[ai][1][m][0], u1 = acc[ai][1][m][1];
                u32x4 w;
                w.x = cvt_pk_bf16(silu_f(g0[0]) * u0[0], silu_f(g0[1]) * u0[1]); w.y = cvt_pk_bf16(silu_f(g0[2]) * u0[2], silu_f(g0[3]) * u0[3]);
                w.z = cvt_pk_bf16(silu_f(g1[0]) * u1[0], silu_f(g1[1]) * u1[1]); w.w = cvt_pk_bf16(silu_f(g1[2]) * u1[2], silu_f(g1[3]) * u1[3]);
                *(u32x4*)rowp = w; }
    }
};
struct EpiResid {
    static constexpr bool PERM = false, AFTER_DRAIN = false;
    const float* base; float* out; const float* gate; int gpitch; float mul;
    __device__ __forceinline__ void operator()(const f32x4 (&acc)[2][2][4][2], const Unit& u, int wr, int wc, int fr, int fq) const {
        const int b = (u.pm * BM) >> 11;
        const int col0 = u.pn * BM + wc * 32 + 4 * fq;
        f32x4 gv[2][2];
#pragma unroll
        for (int bj = 0; bj < 2; ++bj)
#pragma unroll
            for (int n = 0; n < 2; ++n) gv[bj][n] = *(const f32x4*)(gate + (size_t)b * gpitch + col0 + bj * HALF + n * 16) * mul;
#pragma unroll
        for (int ai = 0; ai < 2; ++ai)
#pragma unroll
            for (int m = 0; m < 4; ++m) { const size_t off = (size_t)(u.pm * BM + ai * HALF + wr * 64 + m * 16 + fr) * 1024 + col0;
#pragma unroll
                for (int bj = 0; bj < 2; ++bj)
#pragma unroll
                    for (int n = 0; n < 2; ++n) { const f32x4 bs = *(const f32x4*)(base + off + bj * HALF + n * 16);
                        *(f32x4*)(out + off + bj * HALF + n * 16) = bs + gv[bj][n] * acc[ai][bj][m][n]; } }
    }
};
template <class Epi, class Sched, bool ALIGN_EPI = false, bool SP2 = false>
__device__ __forceinline__ void gemm_phase(PG8_LAS unsigned char* lds, const Gemm g, const Sched& S, const Epi& E) {
    const int tid = tid_l(), wid = __builtin_amdgcn_readfirstlane(tid >> 6), lane = tid & 63, wr = wid >> 2, wc = wid & 3, fr = lane & 15, fq = lane >> 4;
    const int K = g.K, nt = K / BK;
    unsigned voffA[2], voffB[2];
#pragma unroll
    for (int i = 0; i < 2; ++i) { int R, C; stage_rc(tid * 16 + i * 8192, R, C); const int Rb = Epi::PERM ? ((R & ~31) + perm32(R & 31)) : R;
        voffA[i] = (unsigned)(R * K + C) * 2u; voffB[i] = (unsigned)(Rb * K + C) * 2u; }
    const size_t kstep = (size_t)(BK * 2);
    const size_t hstep = (size_t)HALF * K * 2;
    const size_t tstep = 2 * hstep;
    const unsigned ldsw = (unsigned)wid * 1024u;
    const int aoff = lds_byte(wr * 64 + fr, fq * 8), boff = lds_byte(wc * 32 + fr, fq * 8);
#define PG8_SA(b, h) (((b) * 2 + (h)) * HTB)
#define PG8_SB(b, h) ((4 + (b) * 2 + (h)) * HTB)
#define PG8_STAGE(bufoff, gbase, voff) do { _Pragma("unroll") for (int _i = 0; _i < 2; ++_i) \
        __builtin_amdgcn_global_load_lds((const unsigned*)((const char*)(gbase) + (voff)[_i]), (PG8_LAS unsigned*)(lds + (bufoff) + ldsw + _i * 8192), 16, 0, 0); } while (0)
#define PG8_LDA(dst, b, h) do { _Pragma("unroll") for (int m = 0; m < 4; ++m) _Pragma("unroll") for (int k = 0; k < 2; ++k) dst[m][k] = *(const PG8_LAS bf16x8*)(lds + PG8_SA(b, h) + aoff + m * 2048 + k * 1024); } while (0)
#define PG8_LDB(dst, b, h) do { _Pragma("unroll") for (int n = 0; n < 2; ++n) _Pragma("unroll") for (int k = 0; k < 2; ++k) dst[n][k] = *(const PG8_LAS bf16x8*)(lds + PG8_SB(b, h) + boff + n * 2048 + k * 1024); } while (0)
#define PG8_MMA(ai, bj, At, Bt) do { __builtin_amdgcn_s_setprio(1); _Pragma("unroll") for (int m = 0; m < 4; ++m) _Pragma("unroll") for (int n = 0; n < 2; ++n) _Pragma("unroll") for (int k = 0; k < 2; ++k) \
        acc[ai][bj][m][n] = __builtin_amdgcn_mfma_f32_16x16x32_bf16(Bt[n][k], At[m][k], acc[ai][bj][m][n], 0, 0, 0); __builtin_amdgcn_s_setprio(0); } while (0)
#define PG8_WAIT_V(n) asm volatile("s_waitcnt vmcnt(" #n ")" ::: "memory")
#define PG8_WAIT_L(n) asm volatile("s_waitcnt lgkmcnt(" #n ")" ::: "memory")
#define PG8_BAR __builtin_amdgcn_s_barrier()
#define PG8_SCHED __builtin_amdgcn_sched_barrier(0)
    Unit cur, nxt; int ui = 0;
    if (!S.next(0, cur)) return;
    f32x4 acc[2][2][4][2];
#pragma unroll
    for (int a = 0; a < 2; ++a)
#pragma unroll
        for (int b = 0; b < 2; ++b)
#pragma unroll
            for (int m = 0; m < 4; ++m)
#pragma unroll
                for (int n = 0; n < 2; ++n) acc[a][b][m][n] = (f32x4){0.f, 0.f, 0.f, 0.f};
    bf16x8 At[4][2], B0[2][2], B1[2][2];
    const char* cA = (const char*)g.A + (size_t)cur.pm * tstep; const char* cB = (const char*)g.Bt + (size_t)cur.pn * tstep;
    S.a_ready(cur);
    if constexpr (SP2) {
        PG8_STAGE(PG8_SB(0, 0), cB, voffB); PG8_STAGE(PG8_SB(0, 1), cB + hstep, voffB); PG8_STAGE(PG8_SA(0, 0), cA, voffA); PG8_STAGE(PG8_SA(0, 1), cA + hstep, voffA);
        if (wr == 1) PG8_BAR;
        PG8_WAIT_V(2); PG8_BAR;
        PG8_STAGE(PG8_SB(1, 0), cB + kstep, voffB); PG8_STAGE(PG8_SA(1, 0), cA + kstep, voffA); PG8_STAGE(PG8_SB(1, 1), cB + hstep + kstep, voffB);
        PG8_WAIT_V(6); PG8_BAR;
    } else {
        PG8_STAGE(PG8_SB(0, 0), cB, voffB); PG8_STAGE(PG8_SA(0, 0), cA, voffA); PG8_STAGE(PG8_SB(0, 1), cB + hstep, voffB); PG8_STAGE(PG8_SA(0, 1), cA + hstep, voffA);
        if (wr == 1) PG8_BAR;
        PG8_WAIT_V(4); PG8_BAR;
        PG8_STAGE(PG8_SB(1, 0), cB + kstep, voffB); PG8_STAGE(PG8_SA(1, 0), cA + kstep, voffA); PG8_STAGE(PG8_SB(1, 1), cB + hstep + kstep, voffB);
        PG8_WAIT_V(6); PG8_BAR;
    }
    for (;;) {
        const bool has_next = S.next(ui + 1, nxt);
        const char* nA = has_next ? (const char*)g.A + (size_t)nxt.pm * tstep : cA; const char* nB = has_next ? (const char*)g.Bt + (size_t)nxt.pn * tstep : cB;
        for (int t = 0; t < nt; t += 2) {
            const bool last = (t == nt - 2);
            const char* a1 = cA + (size_t)(t + 1) * kstep;
            const char* a2 = last ? nA : cA + (size_t)(t + 2) * kstep; const char* b2 = last ? nB : cB + (size_t)(t + 2) * kstep;
            const char* a3 = a2 + kstep; const char* b3 = b2 + kstep;
            if (last && has_next) S.a_ready(nxt);
            if constexpr (SP2) {
            PG8_LDB(B0, 0, 0); PG8_LDB(B1, 0, 1); PG8_SCHED; PG8_LDA(At, 0, 0); PG8_STAGE(PG8_SA(1, 1), a1 + hstep, voffA);
            PG8_WAIT_V(8); PG8_WAIT_L(0); PG8_BAR; PG8_MMA(0, 0, At, B0); PG8_MMA(0, 1, At, B1); PG8_BAR; PG8_SCHED;
            PG8_LDA(At, 0, 1); PG8_STAGE(PG8_SB(0, 0), b2, voffB); PG8_STAGE(PG8_SB(0, 1), b2 + hstep, voffB); PG8_STAGE(PG8_SA(0, 0), a2, voffA);
            PG8_WAIT_V(8); PG8_WAIT_L(0); PG8_BAR; PG8_MMA(1, 0, At, B0); PG8_MMA(1, 1, At, B1); PG8_BAR; PG8_SCHED;
            PG8_LDB(B0, 1, 0); PG8_LDB(B1, 1, 1); PG8_SCHED; PG8_LDA(At, 1, 0); PG8_STAGE(PG8_SA(0, 1), a2 + hstep, voffA);
            PG8_WAIT_V(8); PG8_WAIT_L(0); PG8_BAR; PG8_MMA(0, 0, At, B0); PG8_MMA(0, 1, At, B1); PG8_BAR; PG8_SCHED;
            PG8_LDA(At, 1, 1); PG8_STAGE(PG8_SB(1, 0), b3, voffB); PG8_STAGE(PG8_SB(1, 1), b3 + hstep, voffB); PG8_STAGE(PG8_SA(1, 0), a3, voffA);
            PG8_WAIT_V(8); PG8_WAIT_L(0); PG8_BAR; PG8_MMA(1, 0, At, B0); PG8_MMA(1, 1, At, B1); PG8_BAR; PG8_SCHED;
            } else {
            PG8_LDB(B0, 0, 0); PG8_SCHED; PG8_LDA(At, 0, 0); PG8_STAGE(PG8_SA(1, 1), a1 + hstep, voffA);
            PG8_WAIT_L(8); PG8_BAR; PG8_WAIT_L(0); PG8_MMA(0, 0, At, B0); PG8_BAR; PG8_SCHED;
            PG8_LDB(B1, 0, 1); PG8_STAGE(PG8_SB(0, 0), b2, voffB);
            PG8_BAR; PG8_WAIT_L(0); PG8_MMA(0, 1, At, B1); PG8_BAR;
            PG8_LDA(At, 0, 1); PG8_STAGE(PG8_SA(0, 0), a2, voffA);
            PG8_BAR; PG8_WAIT_L(0); PG8_MMA(1, 0, At, B0); PG8_BAR; PG8_SCHED;
            PG8_STAGE(PG8_SB(0, 1), b2 + hstep, voffB);
            PG8_WAIT_V(6); PG8_BAR; PG8_MMA(1, 1, At, B1); PG8_BAR;
            PG8_LDB(B0, 1, 0); PG8_SCHED; PG8_LDA(At, 1, 0); PG8_STAGE(PG8_SA(0, 1), a2 + hstep, voffA);
            PG8_WAIT_L(8); PG8_BAR; PG8_WAIT_L(0); PG8_MMA(0, 0, At, B0); PG8_BAR; PG8_SCHED;
            PG8_LDB(B1, 1, 1); PG8_STAGE(PG8_SB(1, 0), b3, voffB);
            PG8_BAR; PG8_WAIT_L(0); PG8_MMA(0, 1, At, B1); PG8_BAR;
            PG8_LDA(At, 1, 1); PG8_STAGE(PG8_SA(1, 0), a3, voffA);
            PG8_BAR; PG8_WAIT_L(0); PG8_MMA(1, 0, At, B0); PG8_BAR; PG8_SCHED;
            PG8_STAGE(PG8_SB(1, 1), b3 + hstep, voffB);
            PG8_WAIT_V(6); PG8_BAR; PG8_MMA(1, 1, At, B1); PG8_BAR;
            }
        }
        if constexpr (ALIGN_EPI) { if (wr == 0) PG8_BAR; }
        if constexpr (!Epi::AFTER_DRAIN) { E(acc, cur, wr, wc, fr, fq); S.done(cur); }
        if (!has_next) break;
#pragma unroll
        for (int a = 0; a < 2; ++a)
#pragma unroll
            for (int b = 0; b < 2; ++b)
#pragma unroll
                for (int m = 0; m < 4; ++m)
#pragma unroll
                    for (int n = 0; n < 2; ++n) acc[a][b][m][n] = (f32x4){0.f, 0.f, 0.f, 0.f};
        cur = nxt; cA = nA; cB = nB; ++ui;
        if constexpr (ALIGN_EPI) { if (wr == 1) PG8_BAR; }
    }
    PG8_WAIT_V(0);
    if constexpr (!ALIGN_EPI) { if (wr == 0) PG8_BAR; }
    PG8_BAR;
    if constexpr (Epi::AFTER_DRAIN) { E.fused(acc, cur, wr, wc, fr, fq, lds, wid, lane); S.done(cur); }
#undef PG8_SA
#undef PG8_SB
#undef PG8_STAGE
#undef PG8_LDA
#undef PG8_LDB
#undef PG8_MMA
#undef PG8_WAIT_V
#undef PG8_WAIT_L
#undef PG8_BAR
#undef PG8_SCHED
}
}
#define LAS __attribute__((address_space(3)))
typedef unsigned short bf16;
typedef float f32x4 __attribute__((ext_vector_type(4)));
typedef float f32x2 __attribute__((ext_vector_type(2)));
typedef unsigned u32x4 __attribute__((ext_vector_type(4)));
typedef unsigned u32x2 __attribute__((ext_vector_type(2)));

constexpr int D = 1024, BATCH = 8, SEQ = 2048, M = BATCH * SEQ, DFF = 2816, NMODC = 9 * 1024, DIN = 3848, NPROJ = 3840;
constexpr int NWAVES = 8, NTHR = 512;
constexpr float EPS = 1e-6f;
constexpr int PC_SBQ = 0, PC_SBK = 256, PC_SBV = 512, PC_GQ = 768, PC_GZ = 2304, PC_HQ = 2816, PC_HF = 3072, PC_HI = 3328, PC_HG = 3584;
constexpr size_t MiB = 1u << 20;
constexpr size_t WS_MOD = 0, MOD_BYTES = (size_t)2 * 8 * NMODC * 4, WS_BAR = 768 * 1024, WS_TASK = 800 * 1024, ZERO_BYTES = 1 * MiB;
constexpr size_t WS_BA = 1 * MiB, WS_GS = 2 * MiB, WS_W1IN = 3 * MiB, WS_W1OUT = 14 * MiB, WS_WMI = 20 * MiB, WS_WMO = 28 * MiB, WS_W2IN = 30 * MiB, WS_W2OUT = 41 * MiB;
constexpr size_t WS_H = 47 * MiB, WS_PROJ = 79 * MiB, WS_QD = 199 * MiB, WS_W = 215 * MiB, WS_U = 231 * MiB, WS_OMIX = 247 * MiB, WS_KDT = 263 * MiB, WS_AQK = 279 * MiB, WS_VT = 287 * MiB, WS_CD = 295 * MiB, WS_P3 = 296 * MiB, WS_END = 304 * MiB;
constexpr int LDS_BYTES = 147456;

struct Params { const float* in[21]; float* out; unsigned char* ws; };

__device__ __forceinline__ float bflo(unsigned u) { return __uint_as_float(u << 16); }
__device__ __forceinline__ float bfhi(unsigned u) { return __uint_as_float(u & 0xffff0000u); }
typedef __bf16 bf16x2v_t __attribute__((ext_vector_type(2)));
__device__ __forceinline__ unsigned pk2(float lo, float hi) { const f32x2 v = {lo, hi}; return __builtin_bit_cast(unsigned, __builtin_convertvector(v, bf16x2v_t)); }
__device__ __forceinline__ unsigned f2bf(float f) { return pk2(f, 0.f) & 0xffffu; }
__device__ __forceinline__ float wave_sum(float v) {
#pragma unroll
    for (int o = 1; o < 64; o <<= 1) v += __shfl_xor(v, o);
    return v;
}
template <int CTRL> __device__ __forceinline__ float dpp_mov(float x) { return __int_as_float(__builtin_amdgcn_update_dpp(0, __float_as_int(x), CTRL, 0xF, 0xF, false)); }
__device__ __forceinline__ float rlane(float x, int l) { return __uint_as_float(__builtin_amdgcn_readlane(__float_as_uint(x), l)); }
__device__ __forceinline__ float wave_sum_fast(float x) {
    x += dpp_mov<0xB1>(x); x += dpp_mov<0x4E>(x); x += dpp_mov<0x141>(x); x += dpp_mov<0x140>(x);
    return (rlane(x, 0) + rlane(x, 16)) + (rlane(x, 32) + rlane(x, 48));
}
__device__ __forceinline__ float silu(float g) { return g * __builtin_amdgcn_rcpf(1.0f + __expf(-g)); }
__device__ __forceinline__ float softplus_precise(float x) { return fmaxf(x, 0.f) + log1pf(expf(-fabsf(x))); }

__device__ __forceinline__ void phase_ada(const Params& p, LAS unsigned char* lds) {
    LAS float* sc = (LAS float*)lds;
    const float* c = p.in[1];
    for (int i = tid_l(); i < 8 * 1024; i += NTHR) { const float v = c[i]; sc[i] = v / (1.0f + expf(-v)); }
    __syncthreads();
    float* MOD = (float*)(p.ws + WS_MOD);
    for (int item = blockIdx.x; item < 288; item += gridDim.x) {
        const int l = item / 144, r = item % 144, cgp = r >> 3, ks = r & 7;
        const int n = cgp * 512 + tid_l();
        const float* W = p.in[18] + (size_t)l * 1024 * NMODC + n;
        float acc[8];
#pragma unroll
        for (int b = 0; b < 8; ++b) acc[b] = 0.f;
        for (int k = ks * 128; k < ks * 128 + 128; ++k) { const float w = W[(size_t)k * NMODC];
#pragma unroll
            for (int b = 0; b < 8; ++b) acc[b] += sc[b * 1024 + k] * w; }
        const float bias = (ks == 0) ? p.in[19][l * NMODC + n] : 0.f;
#pragma unroll
        for (int b = 0; b < 8; ++b) atomicAdd(&MOD[(size_t)(l * 8 + b) * NMODC + n], acc[b] + bias);
    }
    __syncthreads();
}

__device__ __forceinline__ void transpose_item(const float* W, int Nsrc, int K, int k0, int nsrc0, bf16* WT, int drow0, LAS float* scr, int lane) {
#pragma unroll 8
    for (int i = 0; i < 32; ++i) { const int kk = 2 * i + (lane >> 5); scr[kk * 33 + (lane & 31)] = W[(size_t)(k0 + kk) * Nsrc + nsrc0 + (lane & 31)]; }
    asm volatile("s_waitcnt lgkmcnt(0)" ::: "memory");
    const int c = lane & 7;
#pragma unroll
    for (int j = 0; j < 4; ++j) { const int n = (lane >> 3) + 8 * j; const LAS float* s = scr + (8 * c) * 33 + n;
        u32x4 o; o.x = pk2(s[0 * 33], s[1 * 33]); o.y = pk2(s[2 * 33], s[3 * 33]); o.z = pk2(s[4 * 33], s[5 * 33]); o.w = pk2(s[6 * 33], s[7 * 33]);
        *(u32x4*)(WT + (size_t)(drow0 + n) * K + k0 + 8 * c) = o; }
    asm volatile("s_waitcnt lgkmcnt(0)" ::: "memory");
}
__device__ __forceinline__ void phase_convert(const Params& p, int l, LAS unsigned char* lds) {
    const int tid_ = tid_l(); const int wave = __builtin_amdgcn_readfirstlane(tid_ >> 6), lane = tid_ & 63;
    LAS float* scr = (LAS float*)(lds + wave * 16384);
    const int gw = blockIdx.x * NWAVES + wave, NGW = gridDim.x * NWAVES;
    unsigned char* ws = p.ws;
    constexpr int I_IN = 16 * 176, I_OUT = 44 * 32, I_MI = 16 * 120, I_MO = 16 * 32;
    constexpr int NITEMS = 2 * (I_IN + I_OUT) + I_MI + I_MO;
    for (int it = gw; it < NITEMS; it += NGW) {
        int r = it;
        if (r < I_IN || (r >= I_IN + I_OUT + I_MI + I_MO && r < 2 * I_IN + I_OUT + I_MI + I_MO)) {
            const bool second = r >= I_IN; if (second) r -= I_IN + I_OUT + I_MI + I_MO;
            const float* W = (second ? p.in[16] : p.in[3]) + (size_t)l * 1024 * 2 * DFF;
            bf16* WT = (bf16*)(ws + (second ? WS_W2IN : WS_W1IN));
            const int kb = r / 176, nb = r % 176, dn0 = nb * 32, pn = dn0 >> 8, bj = (dn0 >> 7) & 1, j = dn0 & 127;
            transpose_item(W, 2 * DFF, 1024, kb * 64, bj * DFF + pn * 128 + j, WT, dn0, scr, lane);
            continue;
        }
        r -= I_IN;
        if (r < I_OUT) { const float* W = p.in[4] + (size_t)l * DFF * 1024; transpose_item(W, 1024, DFF, (r / 32) * 64, (r % 32) * 32, (bf16*)(ws + WS_W1OUT), (r % 32) * 32, scr, lane); continue; }
        r -= I_OUT;
        if (r < I_MI) { const float* W = p.in[6] + (size_t)l * 1024 * DIN; const int dn0 = (r % 120) * 32; transpose_item(W, DIN, 1024, (r / 120) * 64, dn0 < 2816 ? dn0 : dn0 + 8, (bf16*)(ws + WS_WMI), dn0, scr, lane); continue; }
        r -= I_MI;
        if (r < I_MO) { const float* W = p.in[14] + (size_t)l * 1024 * 1024; transpose_item(W, 1024, 1024, (r / 32) * 64, (r % 32) * 32, (bf16*)(ws + WS_WMO), (r % 32) * 32, scr, lane); continue; }
        r -= I_MO; r -= I_IN;
        { const float* W = p.in[17] + (size_t)l * DFF * 1024; transpose_item(W, 1024, DFF, (r / 32) * 64, (r % 32) * 32, (bf16*)(ws + WS_W2OUT), (r % 32) * 32, scr, lane); }
    }
}

template <bool WITH_BA>
__device__ __forceinline__ void phase_norm(const float* X, const float* gain, const float* shiftp, const float* scalep, bf16* H,
                                           const float* wmi, float* BAout, LAS unsigned char* lds) {
    const int tid_ = tid_l(); const int wave = __builtin_amdgcn_readfirstlane(tid_ >> 6), lane = tid_ & 63;
    LAS float* wba = (LAS float*)lds;
    if (WITH_BA) {
        for (int i = tid_; i < 1024 * 8; i += NTHR) wba[i] = wmi[(size_t)(i >> 3) * DIN + 2816 + (i & 7)];
        __syncthreads();
    }
    const int gw = blockIdx.x * NWAVES + wave, NGW = gridDim.x * NWAVES;
    for (int rg = gw; rg < M / 8; rg += NGW) {
        const int b = (rg * 8) >> 11;
        f32x4 gp[4], sh[4];
#pragma unroll
        for (int j = 0; j < 4; ++j) { const int col = 256 * j + 4 * lane;
            const f32x4 g = *(const f32x4*)(gain + col), s = *(const f32x4*)(scalep + (size_t)b * NMODC + col);
            gp[j] = g * (1.0f + s); sh[j] = *(const f32x4*)(shiftp + (size_t)b * NMODC + col); }
        for (int i = 0; i < 8; ++i) {
            const int m = rg * 8 + i;
            f32x4 v[4]; float ss = 0.f;
#pragma unroll
            for (int j = 0; j < 4; ++j) { v[j] = *(const f32x4*)(X + (size_t)m * D + 256 * j + 4 * lane); ss += (v[j].x * v[j].x + v[j].y * v[j].y) + (v[j].z * v[j].z + v[j].w * v[j].w); }
            const float rstd = __builtin_amdgcn_rsqf(wave_sum(ss) * (1.0f / D) + EPS);
#pragma unroll
            for (int j = 0; j < 4; ++j) { v[j] = v[j] * rstd * gp[j] + sh[j];
                u32x2 o; o.x = pk2(v[j].x, v[j].y); o.y = pk2(v[j].z, v[j].w);
                *(u32x2*)(H + (size_t)m * D + 256 * j + 4 * lane) = o; }
            if (WITH_BA) {
                float acc[8];
#pragma unroll
                for (int q = 0; q < 8; ++q) acc[q] = 0.f;
#pragma unroll
                for (int j = 0; j < 4; ++j)
#pragma unroll
                    for (int e = 0; e < 4; ++e) { const int k = 256 * j + 4 * lane + e; const f32x4 w0 = *(const LAS f32x4*)(wba + k * 8), w1 = *(const LAS f32x4*)(wba + k * 8 + 4); const float hv = v[j][e];
                        acc[0] += hv * w0.x; acc[1] += hv * w0.y; acc[2] += hv * w0.z; acc[3] += hv * w0.w; acc[4] += hv * w1.x; acc[5] += hv * w1.y; acc[6] += hv * w1.z; acc[7] += hv * w1.w; }
#pragma unroll
                for (int q = 0; q < 8; ++q) acc[q] = wave_sum(acc[q]);
                if (lane == 0) { *(f32x4*)(BAout + (size_t)m * 8) = (f32x4){acc[0], acc[1], acc[2], acc[3]}; *(f32x4*)(BAout + (size_t)m * 8 + 4) = (f32x4){acc[4], acc[5], acc[6], acc[7]}; }
            }
        }
    }
    if (WITH_BA) __syncthreads();
}

__device__ __forceinline__ void phase_final(float* X, const float* gain) {
    const int tid_ = tid_l(); const int wave = __builtin_amdgcn_readfirstlane(tid_ >> 6), lane = tid_ & 63;
    const int gw = blockIdx.x * NWAVES + wave, NGW = gridDim.x * NWAVES;
    f32x4 g[4];
#pragma unroll
    for (int j = 0; j < 4; ++j) g[j] = *(const f32x4*)(gain + 256 * j + 4 * lane);
    for (int m = gw; m < M; m += NGW) {
        f32x4 v[4]; float ss = 0.f;
#pragma unroll
        for (int j = 0; j < 4; ++j) { v[j] = *(const f32x4*)(X + (size_t)m * D + 256 * j + 4 * lane); ss += (v[j].x * v[j].x + v[j].y * v[j].y) + (v[j].z * v[j].z + v[j].w * v[j].w); }
        const float rstd = __builtin_amdgcn_rsqf(wave_sum(ss) * (1.0f / D) + EPS);
#pragma unroll
        for (int j = 0; j < 4; ++j) *(f32x4*)(X + (size_t)m * D + 256 * j + 4 * lane) = v[j] * rstd * g[j];
    }
}

#define LDS_BARRIER() do { asm volatile("s_waitcnt lgkmcnt(0)" ::: "memory"); __builtin_amdgcn_s_barrier(); asm volatile("" ::: "memory"); } while (0)
typedef short bf16x8_t __attribute__((ext_vector_type(8)));
__device__ __forceinline__ void phase_prep(const Params& p, int l, LAS unsigned char* lds) {
    const int tid_ = tid_l(); const int wave = __builtin_amdgcn_readfirstlane(tid_ >> 6), lane = tid_ & 63;
    const int gw = blockIdx.x * NWAVES + wave, NGW = gridDim.x * NWAVES;
    const bf16* PROJ = (const bf16*)(p.ws + WS_PROJ); const float* BA = (const float*)(p.ws + WS_BA);
    {
        LAS bf16* tile = (LAS bf16*)(lds + wave * 16384); bf16* VT = (bf16*)(p.ws + WS_VT);
        for (int item = gw; item < 1024; item += NGW) {
            const int bh = item >> 5, tb = item & 31, b = bh >> 2, h = bh & 3; const size_t mt = (size_t)b * SEQ + tb * 64;
            for (int r = 0; r < 64; ++r) tile[r * 66 + lane] = PROJ[(mt + r) * NPROJ + PC_SBV + h * 64 + lane];
            asm volatile("s_waitcnt lgkmcnt(0)" ::: "memory");
            for (int d = 0; d < 64; ++d) VT[((size_t)bh * 64 + d) * SEQ + tb * 64 + lane] = tile[lane * 66 + d];
            asm volatile("s_waitcnt lgkmcnt(0)" ::: "memory");
        }
        __syncthreads();
    }
    bf16* QD = (bf16*)(p.ws + WS_QD); bf16* Wg = (bf16*)(p.ws + WS_W); bf16* Ug = (bf16*)(p.ws + WS_U);
    bf16* KDT = (bf16*)(p.ws + WS_KDT); bf16* AQK = (bf16*)(p.ws + WS_AQK); float* CD = (float*)(p.ws + WS_CD);
    const float* cw = p.in[7] + (size_t)l * 4 * 1536; const float* A_log = p.in[8] + l * 4; const float* dtb = p.in[9] + l * 4;
    LAS bf16* Kb = (LAS bf16*)lds; LAS bf16* Qb = Kb + 64 * 136; LAS bf16* Vb = Qb + 64 * 136;
    LAS float* Akk = (LAS float*)(lds + 3 * 17408);
    LAS float* s_la = Akk + 64 * 68; LAS float* s_beta = s_la + 64; LAS float* s_g = s_beta + 64; LAS float* s_eg = s_g + 64;
    const int g = lane >> 4, c = lane & 15;
    for (int unit = blockIdx.x; unit < 1024; unit += gridDim.x) {
        const int bh = unit >> 5, n = unit & 31, b = bh >> 2, h = bh & 3; const size_t m0 = (size_t)b * SEQ + n * 64;
#pragma unroll 2
        for (int i = 0; i < 8; ++i) {
            const int r = wave * 8 + i, t = n * 64 + r, cq = h * 128 + 2 * lane; const size_t m = m0 + r;
            float q0 = 0.f, q1 = 0.f, k0 = 0.f, k1 = 0.f, v0 = 0.f, v1 = 0.f;
#pragma unroll
            for (int j = 0; j < 4; ++j) {
                if (t - 3 + j >= 0) {
                    const bf16* row = PROJ + (m - 3 + j) * NPROJ + PC_GQ + cq;
                    const unsigned uq = *(const unsigned*)row, uk = *(const unsigned*)(row + 512), uv = *(const unsigned*)(row + 1024);
                    const f32x2 wq = *(const f32x2*)(cw + j * 1536 + cq), wk = *(const f32x2*)(cw + j * 1536 + 512 + cq), wv = *(const f32x2*)(cw + j * 1536 + 1024 + cq);
                    q0 += wq.x * bflo(uq); q1 += wq.y * bfhi(uq); k0 += wk.x * bflo(uk); k1 += wk.y * bfhi(uk); v0 += wv.x * bflo(uv); v1 += wv.y * bfhi(uv);
                }
            }
            q0 = silu(q0); q1 = silu(q1); k0 = silu(k0); k1 = silu(k1); v0 = silu(v0); v1 = silu(v1);
            const float sq = wave_sum_fast(q0 * q0 + q1 * q1), sk = wave_sum_fast(k0 * k0 + k1 * k1);
            const float rq = (__builtin_amdgcn_rsqf(sq + EPS)) * 0.08838834764831845f, rk = __builtin_amdgcn_rsqf(sk + EPS);
            *(LAS unsigned*)(Qb + r * 136 + 2 * lane) = pk2(q0 * rq, q1 * rq); *(LAS unsigned*)(Kb + r * 136 + 2 * lane) = pk2(k0 * rk, k1 * rk); *(LAS unsigned*)(Vb + r * 136 + 2 * lane) = pk2(v0, v1);
            if (lane == 0) {
                s_beta[r] = 1.0f / (1.0f + expf(-BA[m * 8 + h]));
                s_la[r] = -expf(A_log[h]) * softplus_precise(BA[m * 8 + 4 + h] + dtb[h]);
            }
        }
        LDS_BARRIER();
        if (wave == 0) { float x = s_la[lane];
#pragma unroll
            for (int o = 1; o < 64; o <<= 1) { const float tmp = __shfl_up(x, o); if (lane >= o) x += tmp; }
            s_g[lane] = x; s_eg[lane] = expf(x); }
        LDS_BARRIER();
        for (int q = 0; q < 4; ++q) {
            const int idx = wave * 4 + q; const bool isQK = idx >= 16; const int ti = (idx >> 2) & 3, tj = idx & 3;
            f32x4 acc = (f32x4){0.f, 0.f, 0.f, 0.f};
            if (tj <= ti) {
                const LAS bf16* X = isQK ? Qb : Kb;
#pragma unroll
                for (int ks = 0; ks < 4; ++ks) { const bf16x8_t a = *(const LAS bf16x8_t*)(X + (16 * ti + c) * 136 + 32 * ks + 8 * g), bb = *(const LAS bf16x8_t*)(Kb + (16 * tj + c) * 136 + 32 * ks + 8 * g);
                    acc = __builtin_amdgcn_mfma_f32_16x16x32_bf16(a, bb, acc, 0, 0, 0); }
            }
#pragma unroll
            for (int i = 0; i < 4; ++i) { const int row = 16 * ti + 4 * g + i, col = 16 * tj + c;
                const float dec = (col <= row) ? __expf(s_g[row] - s_g[col]) : 0.f;
                if (isQK) AQK[((size_t)unit * 64 + row) * 64 + col] = (bf16)f2bf(dec * acc[i]);
                else Akk[col * 68 + row] = (col < row) ? s_beta[row] * dec * acc[i] : 0.f; }
        }
        LDS_BARRIER();
        if (wave < 4) {
            const bool isW = wave >= 2; const int col = tid_ & 127;
            const LAS bf16* src = isW ? Kb : Vb; bf16* dst = (isW ? Wg : Ug) + m0 * 512 + h * 128 + col;
            float X[64];
            int lz; asm volatile("v_mov_b32 %0, 0" : "=v"(lz));
            const LAS float* Ak = Akk + lz; const LAS float* sb_ = s_beta + lz; const LAS float* se_ = s_eg + lz;
#pragma unroll
            for (int i = 0; i < 64; ++i) { X[i] = sb_[i] * (isW ? se_[i] : 1.0f) * __uint_as_float((unsigned)src[i * 136 + col] << 16);
                if ((i & 7) == 7) asm volatile("" : "+v"(X[i - 7]), "+v"(X[i - 6]), "+v"(X[i - 5]), "+v"(X[i - 4]), "+v"(X[i - 3]), "+v"(X[i - 2]), "+v"(X[i - 1]), "+v"(X[i]) :: "memory"); }
#pragma unroll
            for (int j = 0; j < 63; ++j) {
                const float xj = X[j];
                *dst = (bf16)f2bf(xj); dst += 512; asm volatile("" : "+v"(dst));
#pragma unroll
                for (int i4 = (j >> 2) << 2; i4 < 64; i4 += 4) { const f32x4 a = *(const LAS f32x4*)(Ak + j * 68 + i4);
                    X[i4] -= a.x * xj; X[i4 + 1] -= a.y * xj; X[i4 + 2] -= a.z * xj; X[i4 + 3] -= a.w * xj; }
                if ((j & 1) == 1) asm volatile("" ::: "memory");
            }
            *dst = (bf16)f2bf(X[63]);
        } else {
            const int t2 = tid_ - 256;
            for (int idx = t2; idx < 64 * 64; idx += 256) { const int r = idx >> 6, dp = idx & 63; const unsigned u = *(const LAS unsigned*)(Qb + r * 136 + 2 * dp); const float e = s_eg[r];
                *(unsigned*)(QD + (m0 + r) * 512 + h * 128 + 2 * dp) = pk2(bflo(u) * e, bfhi(u) * e); }
            const int cc = t2 & 63; const float kd = __expf(s_g[63] - s_g[cc]);
            for (int d = t2 >> 6; d < 128; d += 4) KDT[((size_t)unit * 128 + d) * 64 + cc] = (bf16)f2bf(__uint_as_float((unsigned)Kb[cc * 136 + d] << 16) * kd);
            if (t2 == 0) CD[unit] = s_eg[63];
        }
        LDS_BARRIER();
    }
}

template <bool DUMMY>
__device__ __forceinline__ void gdn_scan_block(const Params& p, int l, int unit, LAS unsigned char* lds) {
    const int tid_ = tid_l(); const int w = __builtin_amdgcn_readfirstlane(tid_ >> 6), lane = tid_ & 63, g = lane >> 4, c = lane & 15;
    const int bh = unit >> 1, eh = unit & 1, b = bh >> 2, h = bh & 3, te = w & 3, rh = w >> 2;
    LAS bf16* ST = (LAS bf16*)lds; LAS bf16* Wb = ST + 64 * 136; LAS bf16* QDb = Wb + 64 * 136; LAS bf16* KDTb = QDb + 64 * 136;
    LAS bf16* AQb = KDTb + 128 * 72; LAS bf16* vnT = AQb + 64 * 72 + w * (16 * 72); LAS bf16* Ub = AQb + 64 * 72 + 8 * 16 * 72;
    const bf16* QD = (const bf16*)(p.ws + WS_QD); const bf16* Wg = (const bf16*)(p.ws + WS_W); const bf16* Ug = (const bf16*)(p.ws + WS_U);
    const bf16* KDT = (const bf16*)(p.ws + WS_KDT); const bf16* AQK = (const bf16*)(p.ws + WS_AQK); const float* CD = (const float*)(p.ws + WS_CD);
    bf16* Uraw = (bf16*)(p.ws + (DUMMY ? WS_KDT : WS_U));
    for (int i = tid_; i < 64 * 136 / 2; i += NTHR) ((LAS unsigned*)ST)[i] = 0u;
    f32x4 S[4];
#pragma unroll
    for (int j = 0; j < 4; ++j) S[j] = (f32x4){0.f, 0.f, 0.f, 0.f};
    u32x4 rW[2], rQ[2], rK[2], rA, rU; float cdn;
#define GDN_FETCH(n_) do { const size_t m0_ = (size_t)b * SEQ + (n_) * 64; const size_t unit_ = (size_t)bh * 32 + (n_); \
        _Pragma("unroll") for (int k_ = 0; k_ < 2; ++k_) { const int idx_ = tid_ + NTHR * k_; const size_t go_ = (m0_ + (idx_ >> 4)) * 512 + h * 128 + 8 * (idx_ & 15); \
            rW[k_] = *(const u32x4*)(Wg + go_); rQ[k_] = *(const u32x4*)(QD + go_); \
            rK[k_] = *(const u32x4*)(KDT + (unit_ * 128 + (idx_ >> 3)) * 64 + 8 * (idx_ & 7)); } \
        rU = *(const u32x4*)(Ug + (m0_ + (tid_ >> 3)) * 512 + h * 128 + 64 * eh + 8 * (tid_ & 7)); \
        rA = *(const u32x4*)(AQK + (unit_ * 64 + (tid_ >> 3)) * 64 + 8 * (tid_ & 7)); cdn = CD[unit_]; } while (0)
#define LDSFENCE() asm volatile("s_waitcnt lgkmcnt(0)" ::: "memory")
    GDN_FETCH(0);
    for (int n = 0; n < 32; ++n) {
        const size_t m0 = (size_t)b * SEQ + n * 64;
#pragma unroll
        for (int k = 0; k < 2; ++k) { const int idx = tid_ + NTHR * k; const int lo = (idx >> 4) * 136 + 8 * (idx & 15);
            *(LAS u32x4*)(Wb + lo) = rW[k]; *(LAS u32x4*)(QDb + lo) = rQ[k];
            *(LAS u32x4*)(KDTb + (idx >> 3) * 72 + 8 * (idx & 7)) = rK[k]; }
        *(LAS u32x4*)(Ub + (tid_ >> 3) * 72 + 8 * (tid_ & 7)) = rU;
        *(LAS u32x4*)(AQb + (tid_ >> 3) * 72 + 8 * (tid_ & 7)) = rA;
        const float cd = cdn;
        LDS_BARRIER();
        if (n + 1 < 32) GDN_FETCH(n + 1);
        bf16x8_t stf[4], af[4][4];
#pragma unroll
        for (int ks = 0; ks < 4; ++ks) stf[ks] = *(const LAS bf16x8_t*)(ST + (16 * te + c) * 136 + 32 * ks + 8 * g);
#pragma unroll
        for (int tc = 0; tc < 4; ++tc)
#pragma unroll
            for (int ks = 0; ks < 4; ++ks) af[tc][ks] = *(const LAS bf16x8_t*)(Wb + (16 * tc + c) * 136 + 32 * ks + 8 * g);
        float uv[4][4];
#pragma unroll
        for (int tc = 0; tc < 4; ++tc)
#pragma unroll
            for (int i = 0; i < 4; ++i) uv[tc][i] = __uint_as_float((unsigned)Ub[(16 * tc + 4 * g + i) * 72 + 16 * te + c] << 16);
        LDSFENCE();
#pragma unroll
        for (int tc = 0; tc < 4; ++tc) {
            f32x4 acc = (f32x4){0.f, 0.f, 0.f, 0.f};
#pragma unroll
            for (int ks = 0; ks < 4; ++ks) acc = __builtin_amdgcn_mfma_f32_16x16x32_bf16(af[tc][ks], stf[ks], acc, 0, 0, 0);
            u32x2 o; o.x = pk2(uv[tc][0] - acc[0], uv[tc][1] - acc[1]); o.y = pk2(uv[tc][2] - acc[2], uv[tc][3] - acc[3]);
            *(LAS u32x2*)(vnT + c * 72 + 16 * tc + 4 * g) = o;
        }
        bf16x8_t vf[2], qf[2][2];
#pragma unroll
        for (int t2 = 0; t2 < 2; ++t2)
#pragma unroll
            for (int ks = 0; ks < 4; ++ks) af[t2][ks] = *(const LAS bf16x8_t*)(QDb + (16 * (2 * rh + t2) + c) * 136 + 32 * ks + 8 * g);
#pragma unroll
        for (int t2 = 0; t2 < 2; ++t2)
#pragma unroll
            for (int ks = 0; ks < 2; ++ks) qf[t2][ks] = *(const LAS bf16x8_t*)(AQb + (16 * (2 * rh + t2) + c) * 72 + 32 * ks + 8 * g);
#pragma unroll
        for (int ks = 0; ks < 2; ++ks) vf[ks] = *(const LAS bf16x8_t*)(vnT + c * 72 + 32 * ks + 8 * g);
        LDSFENCE();
        f32x4 ot[2];
#pragma unroll
        for (int t2 = 0; t2 < 2; ++t2) {
            f32x4 acc = (f32x4){0.f, 0.f, 0.f, 0.f};
#pragma unroll
            for (int ks = 0; ks < 4; ++ks) acc = __builtin_amdgcn_mfma_f32_16x16x32_bf16(af[t2][ks], stf[ks], acc, 0, 0, 0);
#pragma unroll
            for (int ks = 0; ks < 2; ++ks) acc = __builtin_amdgcn_mfma_f32_16x16x32_bf16(qf[t2][ks], vf[ks], acc, 0, 0, 0);
            ot[t2] = acc;
        }
#pragma unroll
        for (int t2 = 0; t2 < 2; ++t2)
#pragma unroll
            for (int i = 0; i < 4; ++i) Uraw[(m0 + 16 * (2 * rh + t2) + 4 * g + i) * 512 + h * 128 + 64 * eh + 16 * te + c] = (bf16)f2bf(ot[t2][i]);
        bf16x8_t kf[4][2];
#pragma unroll
        for (int j = 0; j < 4; ++j)
#pragma unroll
            for (int ks = 0; ks < 2; ++ks) kf[j][ks] = *(const LAS bf16x8_t*)(KDTb + (16 * (4 * rh + j) + c) * 72 + 32 * ks + 8 * g);
        LDSFENCE();
#pragma unroll
        for (int j = 0; j < 4; ++j) {
            f32x4 acc = S[j] * cd;
#pragma unroll
            for (int ks = 0; ks < 2; ++ks) acc = __builtin_amdgcn_mfma_f32_16x16x32_bf16(kf[j][ks], vf[ks], acc, 0, 0, 0);
            S[j] = acc;
        }
        LDS_BARRIER();
#pragma unroll
        for (int j = 0; j < 4; ++j) { u32x2 o; o.x = pk2(S[j][0], S[j][1]); o.y = pk2(S[j][2], S[j][3]);
            *(LAS u32x2*)(ST + (16 * te + c) * 136 + 16 * (4 * rh + j) + 4 * g) = o; }
        LDS_BARRIER();
    }
#undef LDSFENCE
#undef GDN_FETCH
}

__device__ __forceinline__ void hgrn_scan_block(const Params& p, int l, int unit, LAS unsigned char* lds) {
    const int tid_ = tid_l(); const int w = __builtin_amdgcn_readfirstlane(tid_ >> 6), lane = tid_ & 63, tt = (lane >> 1) & 15, dd = lane & 1;
    const int bh = unit >> 2, dq = unit & 3, b = bh >> 2, h = bh & 3; const size_t m0 = (size_t)b * SEQ;
    LAS float* coef = (LAS float*)lds + w * (16 * 8);
    LAS float* part = (LAS float*)(lds + 4096);
    LAS bf16* vst = (LAS bf16*)(lds + 4096 + 65536);
    LAS bf16* qst = vst + 2 * 128 * 64;
    LAS bf16* fst = qst + 2 * 128 * 16;
    const bf16* PROJ = (const bf16*)(p.ws + WS_PROJ);
    bf16* OUT = dq == 0 ? (bf16*)(p.ws + WS_H) + m0 * D + 768 + h * 64 + lane
              : (dq == 3 ? (bf16*)(p.ws + WS_P3) : (bf16*)(p.ws + WS_OMIX) + (size_t)(dq - 1) * M * 256) + m0 * 256 + h * 64 + lane;
    const int opitch = dq ? 256 : D;
    const int dcol = h * 64 + 16 * dq + 2 * w + dd;
    float lb = 0.f;
    if (l == 1) lb = 1.0f / (1.0f + expf(p.in[13][dcol] - p.in[13][256 + dcol]));
    f32x2 S2 = (f32x2){0.f, 0.f};
    u32x4 rv[2], rq;
    const bf16* gq = PROJ + m0 * NPROJ + (tid_ < 256 ? PC_HQ : PC_HF) + h * 64 + 16 * dq + 8 * (tid_ & 1);
#define HG_FETCH(sg_) do { const size_t t0_ = (size_t)(sg_) * 128; \
        _Pragma("unroll") for (int k_ = 0; k_ < 2; ++k_) { const int idx_ = tid_ + NTHR * k_; rv[k_] = *(const u32x4*)(PROJ + (m0 + t0_ + (idx_ >> 3)) * NPROJ + PC_HI + h * 64 + 8 * (idx_ & 7)); } \
        rq = *(const u32x4*)(gq + (t0_ + ((tid_ & 255) >> 1)) * NPROJ); } while (0)
#define HG_STAGE(sb_) do { \
        _Pragma("unroll") for (int k_ = 0; k_ < 2; ++k_) { const int idx_ = tid_ + NTHR * k_; *(LAS u32x4*)(vst + (sb_) * 128 * 64 + (idx_ >> 3) * 64 + 8 * (idx_ & 7)) = rv[k_]; } \
        *(LAS u32x4*)((tid_ < 256 ? qst : fst) + (sb_) * 128 * 16 + ((tid_ & 255) >> 1) * 16 + 8 * (tid_ & 1)) = rq; } while (0)
    unsigned ypend[2] = {0u, 0u};
    HG_FETCH(0);
    HG_STAGE(0);
    LDS_BARRIER();
    for (int sg = 0; sg < SEQ / 128; ++sg) {
        const int sb = sg & 1;
        if (sg + 1 < SEQ / 128) HG_FETCH(sg + 1);
        for (int g8 = 0; g8 < 8; ++g8) {
            const int grp = sg * 8 + g8, buf = grp & 1, r0 = g8 * 16;
            if (grp > 0) {
#pragma unroll
                for (int k = 0; k < 2; ++k) OUT[(size_t)((grp - 1) * 16 + 2 * w + k) * opitch] = (bf16)ypend[k];
            }
            {   const float hq = __uint_as_float((unsigned)qst[sb * 128 * 16 + (r0 + tt) * 16 + 2 * w + dd] << 16), fp = __uint_as_float((unsigned)fst[sb * 128 * 16 + (r0 + tt) * 16 + 2 * w + dd] << 16);
                const float en = __expf(-fabsf(fp)), rd = __builtin_amdgcn_rcpf(1.0f + en), sg_ = fp >= 0.f ? rd : en * rd, sn = fp >= 0.f ? en * rd : rd;
                LAS float* cr = coef + tt * 8 + dd;
                if (lane < 32) { cr[0] = lb + (1.0f - lb) * sg_; cr[2] = (1.0f - lb) * sn; cr[4] = silu(hq); } }
            unsigned vraw[16];
#pragma unroll
            for (int s = 0; s < 16; ++s) vraw[s] = vst[sb * 128 * 64 + (r0 + s) * 64 + lane];
            float pacc[16];
            f32x4 ca[16]; f32x2 cb[16];
#pragma unroll
            for (int s = 0; s < 16; ++s) { ca[s] = ((const LAS f32x4*)(coef + s * 8))[0]; cb[s] = ((const LAS f32x2*)(coef + s * 8))[2]; }
#pragma unroll
            for (int s = 0; s < 16; ++s) {
                const float vv = __uint_as_float(vraw[s] << 16); const f32x2 v2 = (f32x2){vv, vv};
                S2 = S2 * (f32x2){ca[s].x, ca[s].y} + (f32x2){ca[s].z, ca[s].w} * v2;
                const f32x2 p2 = cb[s] * S2;
                pacc[s] = p2.x + p2.y;
            }
#pragma unroll
            for (int s = 0; s < 16; ++s) part[((buf * 8 + w) * 16 + s) * 64 + lane] = pacc[s];
            LDS_BARRIER();
#pragma unroll
            for (int k = 0; k < 2; ++k) { const int s = 2 * w + k; float o = 0.f;
#pragma unroll
                for (int ww = 0; ww < 8; ++ww) o += part[((buf * 8 + ww) * 16 + s) * 64 + lane];
                ypend[k] = f2bf(o); }
        }
        if (sg + 1 < SEQ / 128) { HG_STAGE(sb ^ 1); LDS_BARRIER(); }
    }
#pragma unroll
    for (int k = 0; k < 2; ++k) OUT[(size_t)((SEQ / 16 - 1) * 16 + 2 * w + k) * opitch] = (bf16)ypend[k];
#undef HG_STAGE
#undef HG_FETCH
}

__device__ __forceinline__ void sb_tile_wave(const Params& p, int l, int task, int lane) {
    const bf16* PROJ = (const bf16*)(p.ws + WS_PROJ); const bf16* VT = (const bf16*)(p.ws + WS_VT); bf16* O = (bf16*)(p.ws + WS_H);
    const int bh = task >> 7, qt = task & 127, b = bh >> 2, h = bh & 3, t0 = qt * 16, g = lane >> 4, c = lane & 15;
    const size_t mb = (size_t)b * SEQ;
    bf16x8_t qfrag[2];
#pragma unroll
    for (int ks = 0; ks < 2; ++ks) qfrag[ks] = *(const bf16x8_t*)(PROJ + (mb + t0 + c) * NPROJ + PC_SBQ + h * 64 + 32 * ks + 8 * g);
    f32x4 oacc[4];
#pragma unroll
    for (int dt = 0; dt < 4; ++dt) oacc[dt] = (f32x4){0.f, 0.f, 0.f, 0.f};
    float carry = 0.f;
    const int tq = t0 + c;
    for (int kb = (t0 + 14) >> 5; kb >= 0; --kb) {
        const int k0 = 32 * kb;
        float w[2][4];
#pragma unroll
        for (int jj = 0; jj < 2; ++jj) {
            const int j = 1 - jj;
            f32x4 acc = (f32x4){0.f, 0.f, 0.f, 0.f};
#pragma unroll
            for (int ks = 0; ks < 2; ++ks) { const bf16x8_t kf = *(const bf16x8_t*)(PROJ + (mb + k0 + 16 * j + c) * NPROJ + PC_SBK + h * 64 + 32 * ks + 8 * g);
                acc = __builtin_amdgcn_mfma_f32_16x16x32_bf16(kf, qfrag[ks], acc, 0, 0, 0); }
            float lk[4], ls[4]; bool valid[4];
#pragma unroll
            for (int i = 0; i < 4; ++i) { const float z = acc[i] * 0.125f; valid[i] = (k0 + 16 * j + 4 * g + i) < tq;
                const float sp = fmaxf(z, 0.f) + __logf(1.0f + __expf(-fabsf(z))); lk[i] = valid[i] ? -sp : 0.f; ls[i] = z - sp; }
            const float suf2 = lk[3], suf1 = lk[3] + lk[2], suf0 = suf1 + lk[1], T = suf0 + lk[0];
            const float T1 = __shfl_down(T, 16), T2 = __shfl_down(T, 32), T3 = __shfl_down(T, 48);
            const float E = (g < 3 ? T1 : 0.f) + (g < 2 ? T2 : 0.f) + (g < 1 ? T3 : 0.f);
            const float Ttot = __shfl(T + E, c);
            const float base = carry + E;
            w[j][0] = valid[0] ? __expf(ls[0] + base + suf0) : 0.f; w[j][1] = valid[1] ? __expf(ls[1] + base + suf1) : 0.f;
            w[j][2] = valid[2] ? __expf(ls[2] + base + suf2) : 0.f; w[j][3] = valid[3] ? __expf(ls[3] + base) : 0.f;
            carry += Ttot;
        }
        u32x4 pu; pu.x = pk2(w[0][0], w[0][1]); pu.y = pk2(w[0][2], w[0][3]); pu.z = pk2(w[1][0], w[1][1]); pu.w = pk2(w[1][2], w[1][3]);
        const bf16x8_t pfrag = __builtin_bit_cast(bf16x8_t, pu);
#pragma unroll
        for (int dt = 0; dt < 4; ++dt) { const bf16* vr = VT + ((size_t)bh * 64 + 16 * dt + c) * SEQ + k0 + 4 * g;
            const u32x2 v0 = *(const u32x2*)vr, v1 = *(const u32x2*)(vr + 16);
            u32x4 vu; vu.x = v0.x; vu.y = v0.y; vu.z = v1.x; vu.w = v1.y;
            oacc[dt] = __builtin_amdgcn_mfma_f32_16x16x32_bf16(__builtin_bit_cast(bf16x8_t, vu), pfrag, oacc[dt], 0, 0, 0); }
        if (__all(carry < -90.0f)) break;
    }
    float ss = 0.f;
#pragma unroll
    for (int dt = 0; dt < 4; ++dt) ss += (oacc[dt][0] * oacc[dt][0] + oacc[dt][1] * oacc[dt][1]) + (oacc[dt][2] * oacc[dt][2] + oacc[dt][3] * oacc[dt][3]);
    ss += __shfl_xor(ss, 16); ss += __shfl_xor(ss, 32);
    const float r = __builtin_amdgcn_rsqf(ss * (1.0f / 64.0f) + EPS);
#pragma unroll
    for (int dt = 0; dt < 4; ++dt) { const f32x4 gn = *(const f32x4*)(p.in[10] + l * 64 + 16 * dt + 4 * g);
        u32x2 o; o.x = pk2(oacc[dt][0] * r * gn.x, oacc[dt][1] * r * gn.y); o.y = pk2(oacc[dt][2] * r * gn.z, oacc[dt][3] * r * gn.w);
        *(u32x2*)(O + (mb + tq) * D + h * 64 + 16 * dt + 4 * g) = o; }
}

__device__ __forceinline__ void phase_scan(const Params& p, int l, LAS unsigned char* lds) {
    if (blockIdx.x < 64) { gdn_scan_block<false>(p, l, blockIdx.x, lds);
#if PROBE == 4
        gdn_scan_block<true>(p, l, blockIdx.x, lds);
#endif
    } else if (blockIdx.x < 192) { hgrn_scan_block(p, l, blockIdx.x - 64, lds);
#if PROBE == 5
        LDS_BARRIER(); hgrn_scan_block(p, l, blockIdx.x - 64, lds);
#endif
    }
    const int tid_ = tid_l(); const int lane = tid_ & 63;
    unsigned* ctr = (unsigned*)(p.ws + WS_TASK) + 64 * l;
    for (;;) {
        unsigned t = 0u;
        if (lane == 0) t = __hip_atomic_fetch_add(ctr, 1u, __ATOMIC_RELAXED, __HIP_MEMORY_SCOPE_AGENT);
        const int task = __builtin_amdgcn_readfirstlane((int)t);
        if (task >= 4096) break;
        sb_tile_wave(p, l, task, lane);
#if PROBE == 6
        sb_tile_wave(p, l, task, lane);
#endif
    }
}

__device__ __forceinline__ void phase_post(const Params& p, int l) {
    const int tid_ = tid_l(); const int wave = __builtin_amdgcn_readfirstlane(tid_ >> 6), lane = tid_ & 63;
    const int gw = blockIdx.x * NWAVES + wave, NGW = gridDim.x * NWAVES;
    const bf16* PROJ = (const bf16*)(p.ws + WS_PROJ); const bf16* P1 = (const bf16*)(p.ws + WS_OMIX); const bf16* Uraw = (const bf16*)(p.ws + WS_U); bf16* O = (bf16*)(p.ws + WS_H);
    const f32x2 gg = *(const f32x2*)(p.in[11] + l * 128 + 2 * lane);
    const f32x4 hg = *(const f32x4*)(p.in[12] + l * 64 + ((4 * lane) & 63));
    for (int m = gw; m < M; m += NGW) {
        unsigned uo[4], uz[4];
#pragma unroll
        for (int h = 0; h < 4; ++h) { uo[h] = *(const unsigned*)(Uraw + (size_t)m * 512 + h * 128 + 2 * lane); uz[h] = *(const unsigned*)(PROJ + (size_t)m * NPROJ + PC_GZ + h * 128 + 2 * lane); }
        const u32x2 a0 = *(const u32x2*)(O + (size_t)m * D + 768 + 4 * lane), a1 = *(const u32x2*)(P1 + (size_t)m * 256 + 4 * lane), a2 = *(const u32x2*)(P1 + ((size_t)M + m) * 256 + 4 * lane), a3 = *(const u32x2*)((const bf16*)(p.ws + WS_P3) + (size_t)m * 256 + 4 * lane), ug = *(const u32x2*)(PROJ + (size_t)m * NPROJ + PC_HG + 4 * lane);
#pragma unroll
        for (int h = 0; h < 4; ++h) { const float o0 = bflo(uo[h]), o1 = bfhi(uo[h]);
            const float r = __builtin_amdgcn_rsqf(wave_sum_fast(o0 * o0 + o1 * o1) * (1.0f / 128.0f) + EPS);
            *(unsigned*)(O + (size_t)m * D + 256 + h * 128 + 2 * lane) = pk2(o0 * r * gg.x * silu(bflo(uz[h])), o1 * r * gg.y * silu(bfhi(uz[h]))); }
        const float x0 = (bflo(a0.x) + bflo(a1.x)) + (bflo(a2.x) + bflo(a3.x)), x1 = (bfhi(a0.x) + bfhi(a1.x)) + (bfhi(a2.x) + bfhi(a3.x)), x2 = (bflo(a0.y) + bflo(a1.y)) + (bflo(a2.y) + bflo(a3.y)), x3 = (bfhi(a0.y) + bfhi(a1.y)) + (bfhi(a2.y) + bfhi(a3.y));
        float ss = (x0 * x0 + x1 * x1) + (x2 * x2 + x3 * x3);
        ss += dpp_mov<0xB1>(ss); ss += dpp_mov<0x4E>(ss); ss += dpp_mov<0x141>(ss); ss += dpp_mov<0x140>(ss);
        const float r = __builtin_amdgcn_rsqf(ss * (1.0f / 64.0f) + EPS);
        u32x2 wv; wv.x = pk2(x0 * r * hg.x * silu(bflo(ug.x)), x1 * r * hg.y * silu(bfhi(ug.x))); wv.y = pk2(x2 * r * hg.z * silu(bflo(ug.y)), x3 * r * hg.w * silu(bfhi(ug.y)));
        *(u32x2*)(O + (size_t)m * D + 768 + 4 * lane) = wv;
    }
}

#define RLX_AGENT __ATOMIC_RELAXED, __HIP_MEMORY_SCOPE_AGENT
#define XB_TMO      128
#define XB_XCNT(j)  (256  + 64 * (j))
#define XB_XSUB(j)  (1280 + 64 * (j))
#define XB_XGEN(j)  (2304 + 64 * (j))
#define XB_TOP      3328
#define XB_TOPGEN   3392
#define XCD_BAR_WORDS 3456
#define XB_SPIN_CAP (1u << 18)

__device__ __forceinline__ unsigned xb_ld(unsigned* p)              { return __hip_atomic_load(p, __ATOMIC_RELAXED, __HIP_MEMORY_SCOPE_AGENT); }
__device__ __forceinline__ unsigned xb_add(unsigned* p, unsigned v) { return __hip_atomic_fetch_add(p, v, __ATOMIC_RELAXED, __HIP_MEMORY_SCOPE_AGENT); }
__device__ __forceinline__ unsigned xb_xcc_id() { return (unsigned)__builtin_amdgcn_s_getreg((3 << 11) | 20) & 0xFu; }
#define XB_SPIN(cond, bar) do { unsigned _sp = 0; while (cond) { __builtin_amdgcn_s_sleep(1); \
    if ((++_sp & 255u) == 0u) { if (xb_ld(&(bar)[XB_TMO])) break; if (_sp > XB_SPIN_CAP) { atomicAdd(&(bar)[XB_TMO], 1u); break; } } } } while (0)

struct XcdBarrier {
    unsigned* bar; unsigned x;
    volatile LAS unsigned* st;
};

__device__ __forceinline__ XcdBarrier xcd_barrier_post(unsigned* bar, volatile LAS unsigned* st) {
    XcdBarrier b; b.bar = bar; b.x = xb_xcc_id(); b.st = st;
    if (threadIdx.x == 0) (void)xb_add(&bar[XB_XCNT(b.x)], 1u);
    return b;
}
__device__ __forceinline__ void xcd_barrier_complete(unsigned* bar, unsigned x, unsigned& nloc, unsigned& nx) {
    const unsigned G = gridDim.x * gridDim.y * gridDim.z;
    unsigned sum, cnt, mine, sp = 0u;
    for (;;) {
        sum = 0u; cnt = 0u; mine = 0u;
#pragma unroll
        for (unsigned j = 0; j < 16; ++j) { const unsigned c = xb_ld(&bar[XB_XCNT(j)]); sum += c; cnt += (c > 0u) ? 1u : 0u; mine = (j == x) ? c : mine; }
        if (sum == G) break;
        __builtin_amdgcn_s_sleep(1);
        if ((++sp & 255u) == 0u) { if (xb_ld(&bar[XB_TMO])) break; if (sp > XB_SPIN_CAP) { atomicAdd(&bar[XB_TMO], 1u); break; } }
    }
    nloc = mine > 0u ? mine : 1u; nx = cnt > 0u ? cnt : 1u;
}

__device__ __forceinline__ void xcd_barrier(const XcdBarrier& b) {
    asm volatile("s_waitcnt vmcnt(0)" ::: "memory");
    __syncthreads();
    if (threadIdx.x == 0) {
        unsigned* bar = b.bar;
        __builtin_amdgcn_s_waitcnt(0);
        unsigned nloc = b.st[0], nx = b.st[1];
        if (nloc == 0u) { xcd_barrier_complete(bar, b.x, nloc, nx); b.st[0] = nloc; b.st[1] = nx; }
        const unsigned old = xb_add(&bar[XB_XSUB(b.x)], 1u);
        const unsigned gen = old / nloc;
        if (old + 1u == (gen + 1u) * nloc) {
            __builtin_amdgcn_fence(__ATOMIC_RELEASE, "agent");
            asm volatile("s_waitcnt vmcnt(0)" ::: "memory");
            const unsigned og = xb_add(&bar[XB_TOP], 1u);
            const unsigned tg = og / nx;
            if (og + 1u == (tg + 1u) * nx) xb_add(&bar[XB_TOPGEN], 1u);
            else XB_SPIN(xb_ld(&bar[XB_TOPGEN]) == tg, bar);
            __builtin_amdgcn_fence(__ATOMIC_ACQUIRE, "agent");
            xb_add(&bar[XB_XGEN(b.x)], 1u);
            asm volatile("s_waitcnt vmcnt(0)" ::: "memory");
        } else {
            XB_SPIN(xb_ld(&bar[XB_XGEN(b.x)]) == gen, bar);
            __builtin_amdgcn_fence(__ATOMIC_ACQUIRE, "agent");
            asm volatile("s_waitcnt vmcnt(0)" ::: "memory");
        }
    }
    __syncthreads();
}

__global__ void __launch_bounds__(NTHR, 2) fwd_megakernel(Params p) {
    extern __shared__ __attribute__((aligned(16))) unsigned char lds_raw[];
    LAS unsigned char* lds = (LAS unsigned char*)lds_raw;
    cg::grid_group grid = cg::this_grid();
#define GRID_SYNC() do { asm volatile("s_waitcnt vmcnt(0) lgkmcnt(0)" ::: "memory"); grid.sync(); __builtin_amdgcn_fence(__ATOMIC_ACQUIRE, "agent"); asm volatile("s_waitcnt vmcnt(0)" ::: "memory"); } while (0)
    unsigned char* ws = p.ws;
    volatile LAS unsigned* bst = (volatile LAS unsigned*)(lds + LDS_BYTES - 16);
    if (threadIdx.x == 0) { bst[0] = 0u; bst[1] = 0u; }
    __syncthreads();
    const XcdBarrier xbar = xcd_barrier_post((unsigned*)(ws + WS_BAR), bst);
#define XSYNC() xcd_barrier(xbar)
    const float* MOD = (const float*)(ws + WS_MOD);
    bf16* H = (bf16*)(ws + WS_H); bf16* ACT = (bf16*)(ws + WS_PROJ); bf16* PROJ = (bf16*)(ws + WS_PROJ);
    float* X = p.out;

    phase_ada(p, lds);
    phase_convert(p, 0, lds);
    GRID_SYNC();
    for (int l = 0; l < 2; ++l) {
        const float* modl = MOD + (size_t)l * 8 * NMODC;
        const float* Xin = (l == 0) ? p.in[0] : X;
        if (l == 1) phase_convert(p, 1, lds);
        phase_norm<false>(Xin, p.in[2] + l * D, modl + 0 * D, modl + 1 * D, H, nullptr, nullptr, lds);
        XSYNC();
        { pg8::Gemm g{H, (const bf16*)(ws + WS_W1IN), M, 2 * DFF, D}; pg8::StaticOrder S; S.init(M, 2 * DFF, gridDim.x, blockIdx.x);
          pg8::EpiSwiglu E{ACT, DFF}; pg8::gemm_phase<pg8::EpiSwiglu, pg8::StaticOrder, true, true>(lds, g, S, E); }
        XSYNC();
#if PROBE == 7
        { pg8::Gemm g{H, (const bf16*)(ws + WS_W1IN), M, 2 * DFF, D}; pg8::StaticOrder S; S.init(M, 2 * DFF, gridDim.x, blockIdx.x);
          pg8::EpiSwiglu E{ACT, DFF}; pg8::gemm_phase<pg8::EpiSwiglu, pg8::StaticOrder, true, true>(lds, g, S, E); }
        XSYNC();
#endif
        { pg8::Gemm g{ACT, (const bf16*)(ws + WS_W1OUT), M, D, DFF}; pg8::StaticOrder S; S.init(M, D, gridDim.x, blockIdx.x);
          pg8::EpiResid E{Xin, X, modl + 2 * D, NMODC, 0.5f}; pg8::gemm_phase<pg8::EpiResid, pg8::StaticOrder, true, true>(lds, g, S, E); }
        XSYNC();
        phase_norm<true>(X, p.in[5] + l * D, modl + 3 * D, modl + 4 * D, H, p.in[6] + (size_t)l * 1024 * DIN, (float*)(ws + WS_BA), lds);
        XSYNC();
        { pg8::Gemm g{H, (const bf16*)(ws + WS_WMI), M, NPROJ, D}; pg8::StaticOrder S; S.init(M, NPROJ, gridDim.x, blockIdx.x);
          pg8::EpiBf16Plain E{PROJ, NPROJ}; pg8::gemm_phase<pg8::EpiBf16Plain, pg8::StaticOrder, true, true>(lds, g, S, E); }
        XSYNC();
#if PROBE == 8
        { pg8::Gemm g{H, (const bf16*)(ws + WS_WMI), M, NPROJ, D}; pg8::StaticOrder S; S.init(M, NPROJ, gridDim.x, blockIdx.x);
          pg8::EpiBf16Plain E{PROJ, NPROJ}; pg8::gemm_phase<pg8::EpiBf16Plain, pg8::StaticOrder, true, true>(lds, g, S, E); }
        XSYNC();
#endif
        phase_prep(p, l, lds);
        XSYNC();
#if PROBE == 2
        phase_prep(p, l, lds);
        XSYNC();
#endif
#if PROBE == 3
        XSYNC(); XSYNC(); XSYNC(); XSYNC(); XSYNC(); XSYNC(); XSYNC(); XSYNC();
#endif
        phase_scan(p, l, lds);
        XSYNC();
#if PROBE == 1
        phase_scan(p, l, lds);
        XSYNC();
#endif
        phase_post(p, l);
        XSYNC();
        { pg8::Gemm g{H, (const bf16*)(ws + WS_WMO), M, D, D}; pg8::StaticOrder S; S.init(M, D, gridDim.x, blockIdx.x);
          pg8::EpiResid E{X, X, modl + 5 * D, NMODC, 1.0f}; pg8::gemm_phase<pg8::EpiResid, pg8::StaticOrder, true, true>(lds, g, S, E); }
        XSYNC();
        phase_norm<false>(X, p.in[15] + l * D, modl + 6 * D, modl + 7 * D, H, nullptr, nullptr, lds);
        XSYNC();
        { pg8::Gemm g{H, (const bf16*)(ws + WS_W2IN), M, 2 * DFF, D}; pg8::StaticOrder S; S.init(M, 2 * DFF, gridDim.x, blockIdx.x);
          pg8::EpiSwiglu E{ACT, DFF}; pg8::gemm_phase<pg8::EpiSwiglu, pg8::StaticOrder, true, true>(lds, g, S, E); }
        XSYNC();
        { pg8::Gemm g{ACT, (const bf16*)(ws + WS_W2OUT), M, D, DFF}; pg8::StaticOrder S; S.init(M, D, gridDim.x, blockIdx.x);
          pg8::EpiResid E{X, X, modl + 8 * D, NMODC, 0.5f}; pg8::gemm_phase<pg8::EpiResid, pg8::StaticOrder, true, true>(lds, g, S, E); }
        XSYNC();
    }
    phase_final(X, p.in[20]);
}

extern "C" void kernel_launch(void* const* d_in, const int* in_sizes, int n_in, void* d_out, int out_size, void* d_ws, size_t ws_size, hipStream_t stream) {
    static int grid = 0;
    if (grid == 0) {
        if (n_in != 21 || out_size != M * D || ws_size < WS_END) { fprintf(stderr, "kernel_launch: unexpected shapes: n_in %d out %d ws %zu (need %zu)\n", n_in, out_size, ws_size, (size_t)WS_END); grid = -1; return; }
        int dev = 0, cus = 0, per_cu = 0;
        hipGetDevice(&dev);
        hipDeviceGetAttribute(&cus, hipDeviceAttributeMultiprocessorCount, dev);
        hipFuncSetAttribute((const void*)fwd_megakernel, hipFuncAttributeMaxDynamicSharedMemorySize, LDS_BYTES);
        hipOccupancyMaxActiveBlocksPerMultiprocessor(&per_cu, (const void*)fwd_megakernel, NTHR, LDS_BYTES);
        if (per_cu < 1) { fprintf(stderr, "kernel_launch: occupancy query says %d blocks per CU\n", per_cu); per_cu = 1; }
        grid = cus * 1;
        (void)hipGetLastError();
    }
    if (grid < 0) return;
    hipMemsetAsync((char*)d_ws + WS_MOD, 0, ZERO_BYTES, stream);
    Params p{};
    for (int i = 0; i < 21; ++i) p.in[i] = (const float*)d_in[i];
    p.out = (float*)d_out; p.ws = (unsigned char*)d_ws;
    void* args[] = {&p};
    hipError_t e = hipLaunchCooperativeKernel((const void*)fwd_megakernel, dim3(grid), dim3(NTHR), args, LDS_BYTES, stream);
    if (e != hipSuccess) fprintf(stderr, "cooperative launch failed: %s (grid %d)\n", hipGetErrorString(e), grid);
}
```

```cpp
#include <hip/hip_runtime.h>
#include <hip/hip_cooperative_groups.h>
#include <cstdio>
#include <cstdint>
namespace cg = cooperative_groups;
#ifndef PROBE
#define PROBE 0
#endif
__device__ __forceinline__ int tid_l() { int t = threadIdx.x; asm volatile("" : "+v"(t)); return t; }
namespace pg8 {
#define PG8_LAS __attribute__((address_space(3)))
typedef unsigned short bf16_t;
typedef short bf16x8 __attribute__((ext_vector_type(8)));
typedef float f32x4 __attribute__((ext_vector_type(4)));
typedef unsigned u32x4 __attribute__((ext_vector_type(4)));
constexpr int BM = 256, BK = 64, HALF = 128, HTB = HALF * BK * 2  , STAGE_BYTES = 8 * HTB, NXCD = 8, WGM = 8;

__host__ __device__ __forceinline__ int lds_byte(int r, int c) { const int st = (r >> 4) * 2 + (c >> 5), rr = r & 15, cc = c & 31, ob = rr * 64 + cc * 2; return st * 1024 + (ob ^ (((ob >> 9) & 1) << 5)); }
__host__ __device__ __forceinline__ void stage_rc(int b, int& R, int& C) { const int st = b / 1024, sb = b % 1024, swz = sb ^ (((sb >> 9) & 1) << 5); R = (st >> 1) * 16 + swz / 64; C = (st & 1) * 32 + (swz % 64) / 2; }
__host__ __device__ __forceinline__ int perm32(int rho) { const int n = rho >> 4, i = rho & 15; return 8 * (i >> 2) + 4 * n + (i & 3); }

struct Unit { int pm, pn; };
struct Gemm { const bf16_t* A; const bf16_t* Bt; int M, N, K; };

struct StaticOrder {
    int nM, nN, nwg, G, c;
    __host__ __device__ void init(int M, int N, int G_, int c_) { nM = M / BM; nN = N / BM; nwg = nM * nN; G = G_; c = c_; }
    __host__ __device__ bool next(int i, Unit& u) const {
        const long L = (long)i * G + c; if (L >= nwg) return false;
        int wgid = (int)L; { const int q = nwg / NXCD, r = nwg % NXCD, xcd = wgid % NXCD, off = wgid / NXCD; wgid = (xcd < r ? xcd * (q + 1) : r * (q + 1) + (xcd - r) * q) + off; }
        const int nig = WGM * nN, gid = wgid / nig, fm = gid * WGM, gsz = (nM - fm) < WGM ? (nM - fm) : WGM;
        u.pm = fm + ((wgid % nig) % gsz); u.pn = (wgid % nig) / gsz; return true;
    }
    __device__ __forceinline__ void a_ready(const Unit&) const {}
    __device__ __forceinline__ void done(const Unit&) const {}
};

typedef __bf16 bf16x2n_t __attribute__((ext_vector_type(2)));
typedef float f32x2n_t __attribute__((ext_vector_type(2)));
__device__ __forceinline__ unsigned cvt_pk_bf16(float lo, float hi) { const f32x2n_t v = {lo, hi}; return __builtin_bit_cast(unsigned, __builtin_convertvector(v, bf16x2n_t)); }
typedef float f32x2 __attribute__((ext_vector_type(2)));
__device__ __forceinline__ float silu_f(float g) { return g * __builtin_amdgcn_rcpf(1.0f + __expf(-g)); }
struct EpiBf16Plain {
    static constexpr bool PERM = true, AFTER_DRAIN = false;
    bf16_t* O; int ldc;
    __device__ __forceinline__ void operator()(const f32x4 (&acc)[2][2][4][2], const Unit& u, int wr, int wc, int fr, int fq) const {
        const int row0 = u.pm * BM + wr * 64 + fr, col0 = u.pn * BM + wc * 32 + 8 * fq;
#pragma unroll
        for (int ai = 0; ai < 2; ++ai)
#pragma unroll
            for (int m = 0; m < 4; ++m) { bf16_t* rowp = O + (size_t)(row0 + ai * HALF + m * 16) * ldc + col0;
#pragma unroll
                for (int bj = 0; bj < 2; ++bj) { const f32x4 v0 = acc[ai][bj][m][0], v1 = acc[ai][bj][m][1];
                    u32x4 w; w.x = cvt_pk_bf16(v0[0], v0[1]); w.y = cvt_pk_bf16(v0[2], v0[3]); w.z = cvt_pk_bf16(v1[0], v1[1]); w.w = cvt_pk_bf16(v1[2], v1[3]);
                    *(u32x4*)(rowp + bj * HALF) = w; } }
    }
};
struct EpiSwiglu {
    static constexpr bool PERM = true, AFTER_DRAIN = false;
    bf16_t* O; int ldc;
    __device__ __forceinline__ void operator()(const f32x4 (&acc)[2][2][4][2], const Unit& u, int wr, int wc, int fr, int fq) const {
        const int row0 = u.pm * BM + wr * 64 + fr, col0 = u.pn * HALF + wc * 32 + 8 * fq;
#pragma unroll
        for (int ai = 0; ai < 2; ++ai)
#pragma unroll
            for (int m = 0; m < 4; ++m) { bf16_t* rowp = O + (size_t)(row0 + ai * HALF + m * 16) * ldc + col0;
                const f32x4 g0 = acc[ai][0][m][0], g1 = acc[ai][0][m][1], u0 = acc[ai][1][m][0], u1 = acc[ai][1][m][1];
                u32x4 w;
                w.x = cvt_pk_bf16(silu_f(g0[0]) * u0[0], silu_f(g0[1]) * u0[1]); w.y = cvt_pk_bf16(silu_f(g0[2]) * u0[2], silu_f(g0[3]) * u0[3]);
                w.z = cvt_pk_bf16(silu_f(g1[0]) * u1[0], silu_f(g1[1]) * u1[1]); w.w = cvt_pk_bf16(silu_f(g1[2]) * u1[2], silu_f(g1[3]) * u1[3]);
                *(u32x4*)rowp = w; }
    }
};
struct EpiResid {
    static constexpr bool PERM = false, AFTER_DRAIN = false;
    const float* base; float* out; const float* gate; int gpitch; float mul;
    __device__ __forceinline__ void operator()(const f32x4 (&acc)[2][2][4][2], const Unit& u, int wr, int wc, int fr, int fq) const {
        const int b = (u.pm * BM) >> 11;
        const int col0 = u.pn * BM + wc * 32 + 4 * fq;
        f32x4 gv[2][2];
#pragma unroll
        for (int bj = 0; bj < 2; ++bj)
#pragma unroll
            for (int n = 0; n < 2; ++n) gv[bj][n] = *(const f32x4*)(gate + (size_t)b * gpitch + col0 + bj * HALF + n * 16) * mul;
#pragma unroll
        for (int ai = 0; ai < 2; ++ai)
#pragma unroll
            for (int m = 0; m < 4; ++m) { const size_t off = (size_t)(u.pm * BM + ai * HALF + wr * 64 + m * 16 + fr) * 1024 + col0;
#pragma unroll
                for (int bj = 0; bj < 2; ++bj)
#pragma unroll
                    for (int n = 0; n < 2; ++n) { const f32x4 bs = *(const f32x4*)(base + off + bj * HALF + n * 16);
                        *(f32x4*)(out + off + bj * HALF + n * 16) = bs + gv[bj][n] * acc[ai][bj][m][n]; } }
    }
};
template <class Epi, class Sched, bool ALIGN_EPI = false, bool SP2 = false>
__device__ __forceinline__ void gemm_phase(PG8_LAS unsigned char* lds, const Gemm g, const Sched& S, const Epi& E) {
    const int tid = tid_l(), wid = __builtin_amdgcn_readfirstlane(tid >> 6), lane = tid & 63, wr = wid >> 2, wc = wid & 3, fr = lane & 15, fq = lane >> 4;
    const int K = g.K, nt = K / BK;
    unsigned voffA[2], voffB[2];
#pragma unroll
    for (int i = 0; i < 2; ++i) { int R, C; stage_rc(tid * 16 + i * 8192, R, C); const int Rb = Epi::PERM ? ((R & ~31) + perm32(R & 31)) : R;
        voffA[i] = (unsigned)(R * K + C) * 2u; voffB[i] = (unsigned)(Rb * K + C) * 2u; }
    const size_t kstep = (size_t)(BK * 2);
    const size_t hstep = (size_t)HALF * K * 2;
    const size_t tstep = 2 * hstep;
    const unsigned ldsw = (unsigned)wid * 1024u;
    const int aoff = lds_byte(wr * 64 + fr, fq * 8), boff = lds_byte(wc * 32 + fr, fq * 8);
#define PG8_SA(b, h) (((b) * 2 + (h)) * HTB)
#define PG8_SB(b, h) ((4 + (b) * 2 + (h)) * HTB)
#define PG8_STAGE(bufoff, gbase, voff) do { _Pragma("unroll") for (int _i = 0; _i < 2; ++_i) \
        __builtin_amdgcn_global_load_lds((const unsigned*)((const char*)(gbase) + (voff)[_i]), (PG8_LAS unsigned*)(lds + (bufoff) + ldsw + _i * 8192), 16, 0, 0); } while (0)
#define PG8_LDA(dst, b, h) do { _Pragma("unroll") for (int m = 0; m < 4; ++m) _Pragma("unroll") for (int k = 0; k < 2; ++k) dst[m][k] = *(const PG8_LAS bf16x8*)(lds + PG8_SA(b, h) + aoff + m * 2048 + k * 1024); } while (0)
#define PG8_LDB(dst, b, h) do { _Pragma("unroll") for (int n = 0; n < 2; ++n) _Pragma("unroll") for (int k = 0; k < 2; ++k) dst[n][k] = *(const PG8_LAS bf16x8*)(lds + PG8_SB(b, h) + boff + n * 2048 + k * 1024); } while (0)
#define PG8_MMA(ai, bj, At, Bt) do { __builtin_amdgcn_s_setprio(1); _Pragma("unroll") for (int m = 0; m < 4; ++m) _Pragma("unroll") for (int n = 0; n < 2; ++n) _Pragma("unroll") for (int k = 0; k < 2; ++k) \
        acc[ai][bj][m][n] = __builtin_amdgcn_mfma_f32_16x16x32_bf16(Bt[n][k], At[m][k], acc[ai][bj][m][n], 0, 0, 0); __builtin_amdgcn_s_setprio(0); } while (0)
#define PG8_WAIT_V(n) asm volatile("s_waitcnt vmcnt(" #n ")" ::: "memory")
#define PG8_WAIT_L(n) asm volatile("s_waitcnt lgkmcnt(" #n ")" ::: "memory")
#define PG8_BAR __builtin_amdgcn_s_barrier()
#define PG8_SCHED __builtin_amdgcn_sched_barrier(0)
    Unit cur, nxt; int ui = 0;
    if (!S.next(0, cur)) return;
    f32x4 acc[2][2][4][2];
#pragma unroll
    for (int a = 0; a < 2; ++a)
#pragma unroll
        for (int b = 0; b < 2; ++b)
#pragma unroll
            for (int m = 0; m < 4; ++m)
#pragma unroll
                for (int n = 0; n < 2; ++n) acc[a][b][m][n] = (f32x4){0.f, 0.f, 0.f, 0.f};
    bf16x8 At[4][2], B0[2][2], B1[2][2];
    const char* cA = (const char*)g.A + (size_t)cur.pm * tstep; const char* cB = (const char*)g.Bt + (size_t)cur.pn * tstep;
    S.a_ready(cur);
    if constexpr (SP2) {
        PG8_STAGE(PG8_SB(0, 0), cB, voffB); PG8_STAGE(PG8_SB(0, 1), cB + hstep, voffB); PG8_STAGE(PG8_SA(0, 0), cA, voffA); PG8_STAGE(PG8_SA(0, 1), cA + hstep, voffA);
        if (wr == 1) PG8_BAR;
        PG8_WAIT_V(2); PG8_BAR;
        PG8_STAGE(PG8_SB(1, 0), cB + kstep, voffB); PG8_STAGE(PG8_SA(1, 0), cA + kstep, voffA); PG8_STAGE(PG8_SB(1, 1), cB + hstep + kstep, voffB);
        PG8_WAIT_V(6); PG8_BAR;
    } else {
        PG8_STAGE(PG8_SB(0, 0), cB, voffB); PG8_STAGE(PG8_SA(0, 0), cA, voffA); PG8_STAGE(PG8_SB(0, 1), cB + hstep, voffB); PG8_STAGE(PG8_SA(0, 1), cA + hstep, voffA);
        if (wr == 1) PG8_BAR;
        PG8_WAIT_V(4); PG8_BAR;
        PG8_STAGE(PG8_SB(1, 0), cB + kstep, voffB); PG8_STAGE(PG8_SA(1, 0), cA + kstep, voffA); PG8_STAGE(PG8_SB(1, 1), cB + hstep + kstep, voffB);
        PG8_WAIT_V(6); PG8_BAR;
    }
    for (;;) {
        const bool has_next = S.next(ui + 1, nxt);
        const char* nA = has_next ? (const char*)g.A + (size_t)nxt.pm * tstep : cA; const char* nB = has_next ? (const char*)g.Bt + (size_t)nxt.pn * tstep : cB;
        for (int t = 0; t < nt; t += 2) {
            const bool last = (t == nt - 2);
            const char* a1 = cA + (size_t)(t + 1) * kstep;
            const char* a2 = last ? nA : cA + (size_t)(t + 2) * kstep; const char* b2 = last ? nB : cB + (size_t)(t + 2) * kstep;
            const char* a3 = a2 + kstep; const char* b3 = b2 + kstep;
            if (last && has_next) S.a_ready(nxt);
            if constexpr (SP2) {
            PG8_LDB(B0, 0, 0); PG8_LDB(B1, 0, 1); PG8_SCHED; PG8_LDA(At, 0, 0); PG8_STAGE(PG8_SA(1, 1), a1 + hstep, voffA);
            PG8_WAIT_V(8); PG8_WAIT_L(0); PG8_BAR; PG8_MMA(0, 0, At, B0); PG8_MMA(0, 1, At, B1); PG8_BAR; PG8_SCHED;
            PG8_LDA(At, 0, 1); PG8_STAGE(PG8_SB(0, 0), b2, voffB); PG8_STAGE(PG8_SB(0, 1), b2 + hstep, voffB); PG8_STAGE(PG8_SA(0, 0), a2, voffA);
            PG8_WAIT_V(8); PG8_WAIT_L(0); PG8_BAR; PG8_MMA(1, 0, At, B0); PG8_MMA(1, 1, At, B1); PG8_BAR; PG8_SCHED;
            PG8_LDB(B0, 1, 0); PG8_LDB(B1, 1, 1); PG8_SCHED; PG8_LDA(At, 1, 0); PG8_STAGE(PG8_SA(0, 1), a2 + hstep, voffA);
            PG8_WAIT_V(8); PG8_WAIT_L(0); PG8_BAR; PG8_MMA(0, 0, At, B0); PG8_MMA(0, 1, At, B1); PG8_BAR; PG8_SCHED;
            PG8_LDA(At, 1, 1); PG8_STAGE(PG8_SB(1, 0), b3, voffB); PG8_STAGE(PG8_SB(1, 1), b3 + hstep, voffB); PG8_STAGE(PG8_SA(1, 0), a3, voffA);
            PG8_WAIT_V(8); PG8_WAIT_L(0); PG8_BAR; PG8_MMA(1, 0, At, B0); PG8_MMA(1, 1, At, B1); PG8_BAR; PG8_SCHED;
            } else {
            PG8_LDB(B0, 0, 0); PG8_SCHED; PG8_LDA(At, 0, 0); PG8_STAGE(PG8_SA(1, 1), a1 + hstep, voffA);
            PG8_WAIT_L(8); PG8_BAR; PG8_WAIT_L(0); PG8_MMA(0, 0, At, B0); PG8_BAR; PG8_SCHED;
            PG8_LDB(B1, 0, 1); PG8_STAGE(PG8_SB(0, 0), b2, voffB);
            PG8_BAR; PG8_WAIT_L(0); PG8_MMA(0, 1, At, B1); PG8_BAR;
            PG8_LDA(At, 0, 1); PG8_STAGE(PG8_SA(0, 0), a2, voffA);
            PG8_BAR; PG8_WAIT_L(0); PG8_MMA(1, 0, At, B0); PG8_BAR; PG8_SCHED;
            PG8_STAGE(PG8_SB(0, 1), b2 + hstep, voffB);
            PG8_WAIT_V(6); PG8_BAR; PG8_MMA(1, 1, At, B1); PG8_BAR;
            PG8_LDB(B0, 1, 0); PG8_SCHED; PG8_LDA(At, 1, 0); PG8_STAGE(PG8_SA(0, 1), a2 + hstep, voffA);
            PG8_WAIT_L(8); PG8_BAR; PG8_WAIT_L(0); PG8_MMA(0, 0, At, B0); PG8_BAR; PG8_SCHED;
            PG8_LDB(B1, 1, 1); PG8_STAGE(PG8_SB(1, 0), b3, voffB);
            PG8_BAR; PG8_WAIT_L(0); PG8_MMA(0, 1, At, B1); PG8_BAR;
            PG8_LDA(At, 1, 1); PG8_STAGE(PG8_SA(1, 0), a3, voffA);
            PG8_BAR; PG8_WAIT_L(0); PG8_MMA(1, 0, At, B0); PG8_BAR; PG8_SCHED;
            PG8_STAGE(PG8_SB(1, 1), b3 + hstep, voffB);
            PG8_WAIT_V(6); PG8_BAR; PG8_MMA(1, 1, At, B1); PG8_BAR;
            }
        }
        if constexpr (ALIGN_EPI) { if (wr == 0) PG8_BAR; }
        if constexpr (!Epi::AFTER_DRAIN) { E(acc, cur, wr, wc, fr, fq); S.done(cur); }
        if (!has_next) break;
#pragma unroll
        for (int a = 0; a < 2; ++a)
#pragma unroll
            for (int b = 0; b < 2; ++b)
#pragma unroll
                for (int m = 0; m < 4; ++m)
#pragma unroll
                    for (int n = 0; n < 2; ++n) acc[a][b][m][n] = (f32x4){0.f, 0.f, 0.f, 0.f};
        cur = nxt; cA = nA; cB = nB; ++ui;
        if constexpr (ALIGN_EPI) { if (wr == 1) PG8_BAR; }
    }
    PG8_WAIT_V(0);
    if constexpr (!ALIGN_EPI) { if (wr == 0) PG8_BAR; }
    PG8_BAR;
    if constexpr (Epi::AFTER_DRAIN) { E.fused(acc, cur, wr, wc, fr, fq, lds, wid, lane); S.done(cur); }
#undef PG8_SA
#undef PG8_SB
#undef PG8_STAGE
#undef PG8_LDA
#undef PG8_LDB
#undef PG8_MMA
#undef PG8_WAIT_V
#undef PG8_WAIT_L
#undef PG8_BAR
#undef PG8_SCHED
}
}
#define LAS __attribute__((address_space(3)))
typedef unsigned short bf16;
typedef float f32x4 __attribute__((ext_vector_type(4)));
typedef float f32x2 __attribute__((ext_vector_type(2)));
typedef unsigned u32x4 __attribute__((ext_vector_type(4)));
typedef unsigned u32x2 __attribute__((ext_vector_type(2)));

constexpr int D = 1024, BATCH = 8, SEQ = 2048, M = BATCH * SEQ, DFF = 2816, NMODC = 9 * 1024, DIN = 3848, NPROJ = 3840;
constexpr int NWAVES = 8, NTHR = 512;
constexpr float EPS = 1e-6f;
constexpr int PC_SBQ = 0, PC_SBK = 256, PC_SBV = 512, PC_GQ = 768, PC_GZ = 2304, PC_HQ = 2816, PC_HF = 3072, PC_HI = 3328, PC_HG = 3584;
constexpr size_t MiB = 1u << 20;
constexpr size_t WS_MOD = 0, MOD_BYTES = (size_t)2 * 8 * NMODC * 4, WS_BAR = 768 * 1024, WS_TASK = 800 * 1024, ZERO_BYTES = 1 * MiB;
constexpr size_t WS_BA = 1 * MiB, WS_GS = 2 * MiB, WS_W1IN = 3 * MiB, WS_W1OUT = 14 * MiB, WS_WMI = 20 * MiB, WS_WMO = 28 * MiB, WS_W2IN = 30 * MiB, WS_W2OUT = 41 * MiB;
constexpr size_t WS_H = 47 * MiB, WS_PROJ = 79 * MiB, WS_QD = 199 * MiB, WS_W = 215 * MiB, WS_U = 231 * MiB, WS_OMIX = 247 * MiB, WS_KDT = 263 * MiB, WS_AQK = 279 * MiB, WS_VT = 287 * MiB, WS_CD = 295 * MiB, WS_P3 = 296 * MiB, WS_END = 304 * MiB;
constexpr int LDS_BYTES = 147456;

struct Params { const float* in[21]; float* out; unsigned char* ws; };

__device__ __forceinline__ float bflo(unsigned u) { return __uint_as_float(u << 16); }
__device__ __forceinline__ float bfhi(unsigned u) { return __uint_as_float(u & 0xffff0000u); }
typedef __bf16 bf16x2v_t __attribute__((ext_vector_type(2)));
__device__ __forceinline__ unsigned pk2(float lo, float hi) { const f32x2 v = {lo, hi}; return __builtin_bit_cast(unsigned, __builtin_convertvector(v, bf16x2v_t)); }
__device__ __forceinline__ unsigned f2bf(float f) { return pk2(f, 0.f) & 0xffffu; }
__device__ __forceinline__ float wave_sum(float v) {
#pragma unroll
    for (int o = 1; o < 64; o <<= 1) v += __shfl_xor(v, o);
    return v;
}
template <int CTRL> __device__ __forceinline__ float dpp_mov(float x) { return __int_as_float(__builtin_amdgcn_update_dpp(0, __float_as_int(x), CTRL, 0xF, 0xF, false)); }
__device__ __forceinline__ float rlane(float x, int l) { return __uint_as_float(__builtin_amdgcn_readlane(__float_as_uint(x), l)); }
__device__ __forceinline__ float wave_sum_fast(float x) {
    x += dpp_mov<0xB1>(x); x += dpp_mov<0x4E>(x); x += dpp_mov<0x141>(x); x += dpp_mov<0x140>(x);
    return (rlane(x, 0) + rlane(x, 16)) + (rlane(x, 32) + rlane(x, 48));
}
__device__ __forceinline__ float silu(float g) { return g * __builtin_amdgcn_rcpf(1.0f + __expf(-g)); }
__device__ __forceinline__ float softplus_precise(float x) { return fmaxf(x, 0.f) + log1pf(expf(-fabsf(x))); }

__device__ __forceinline__ void phase_ada(const Params& p, LAS unsigned char* lds) {
    LAS float* sc = (LAS float*)lds;
    const float* c = p.in[1];
    for (int i = tid_l(); i < 8 * 1024; i += NTHR) { const float v = c[i]; sc[i] = v / (1.0f + expf(-v)); }
    __syncthreads();
    float* MOD = (float*)(p.ws + WS_MOD);
    for (int item = blockIdx.x; item < 288; item += gridDim.x) {
        const int l = item / 144, r = item % 144, cgp = r >> 3, ks = r & 7;
        const int n = cgp * 512 + tid_l();
        const float* W = p.in[18] + (size_t)l * 1024 * NMODC + n;
        float acc[8];
#pragma unroll
        for (int b = 0; b < 8; ++b) acc[b] = 0.f;
        for (int k = ks * 128; k < ks * 128 + 128; ++k) { const float w = W[(size_t)k * NMODC];
#pragma unroll
            for (int b = 0; b < 8; ++b) acc[b] += sc[b * 1024 + k] * w; }
        const float bias = (ks == 0) ? p.in[19][l * NMODC + n] : 0.f;
#pragma unroll
        for (int b = 0; b < 8; ++b) atomicAdd(&MOD[(size_t)(l * 8 + b) * NMODC + n], acc[b] + bias);
    }
    __syncthreads();
}

__device__ __forceinline__ void transpose_item(const float* W, int Nsrc, int K, int k0, int nsrc0, bf16* WT, int drow0, LAS float* scr, int lane) {
#pragma unroll 8
    for (int i = 0; i < 32; ++i) { const int kk = 2 * i + (lane >> 5); scr[kk * 33 + (lane & 31)] = W[(size_t)(k0 + kk) * Nsrc + nsrc0 + (lane & 31)]; }
    asm volatile("s_waitcnt lgkmcnt(0)" ::: "memory");
    const int c = lane & 7;
#pragma unroll
    for (int j = 0; j < 4; ++j) { const int n = (lane >> 3) + 8 * j; const LAS float* s = scr + (8 * c) * 33 + n;
        u32x4 o; o.x = pk2(s[0 * 33], s[1 * 33]); o.y = pk2(s[2 * 33], s[3 * 33]); o.z = pk2(s[4 * 33], s[5 * 33]); o.w = pk2(s[6 * 33], s[7 * 33]);
        *(u32x4*)(WT + (size_t)(drow0 + n) * K + k0 + 8 * c) = o; }
    asm volatile("s_waitcnt lgkmcnt(0)" ::: "memory");
}
__device__ __forceinline__ void phase_convert(const Params& p, int l, LAS unsigned char* lds) {
    const int tid_ = tid_l(); const int wave = __builtin_amdgcn_readfirstlane(tid_ >> 6), lane = tid_ & 63;
    LAS float* scr = (LAS float*)(lds + wave * 16384);
    const int gw = blockIdx.x * NWAVES + wave, NGW = gridDim.x * NWAVES;
    unsigned char* ws = p.ws;
    constexpr int I_IN = 16 * 176, I_OUT = 44 * 32, I_MI = 16 * 120, I_MO = 16 * 32;
    constexpr int NITEMS = 2 * (I_IN + I_OUT) + I_MI + I_MO;
    for (int it = gw; it < NITEMS; it += NGW) {
        int r = it;
        if (r < I_IN || (r >= I_IN + I_OUT + I_MI + I_MO && r < 2 * I_IN + I_OUT + I_MI + I_MO)) {
            const bool second = r >= I_IN; if (second) r -= I_IN + I_OUT + I_MI + I_MO;
            const float* W = (second ? p.in[16] : p.in[3]) + (size_t)l * 1024 * 2 * DFF;
            bf16* WT = (bf16*)(ws + (second ? WS_W2IN : WS_W1IN));
            const int kb = r / 176, nb = r % 176, dn0 = nb * 32, pn = dn0 >> 8, bj = (dn0 >> 7) & 1, j = dn0 & 127;
            transpose_item(W, 2 * DFF, 1024, kb * 64, bj * DFF + pn * 128 + j, WT, dn0, scr, lane);
            continue;
        }
        r -= I_IN;
        if (r < I_OUT) { const float* W = p.in[4] + (size_t)l * DFF * 1024; transpose_item(W, 1024, DFF, (r / 32) * 64, (r % 32) * 32, (bf16*)(ws + WS_W1OUT), (r % 32) * 32, scr, lane); continue; }
        r -= I_OUT;
        if (r < I_MI) { const float* W = p.in[6] + (size_t)l * 1024 * DIN; const int dn0 = (r % 120) * 32; transpose_item(W, DIN, 1024, (r / 120) * 64, dn0 < 2816 ? dn0 : dn0 + 8, (bf16*)(ws + WS_WMI), dn0, scr, lane); continue; }
        r -= I_MI;
        if (r < I_MO) { const float* W = p.in[14] + (size_t)l * 1024 * 1024; transpose_item(W, 1024, 1024, (r / 32) * 64, (r % 32) * 32, (bf16*)(ws + WS_WMO), (r % 32) * 32, scr, lane); continue; }
        r -= I_MO; r -= I_IN;
        { const float* W = p.in[17] + (size_t)l * DFF * 1024; transpose_item(W, 1024, DFF, (r / 32) * 64, (r % 32) * 32, (bf16*)(ws + WS_W2OUT), (r % 32) * 32, scr, lane); }
    }
}

template <bool WITH_BA>
__device__ __forceinline__ void phase_norm(const float* X, const float* gain, const float* shiftp, const float* scalep, bf16* H,
                                           const float* wmi, float* BAout, LAS unsigned char* lds) {
    const int tid_ = tid_l(); const int wave = __builtin_amdgcn_readfirstlane(tid_ >> 6), lane = tid_ & 63;
    LAS float* wba = (LAS float*)lds;
    if (WITH_BA) {
        for (int i = tid_; i < 1024 * 8; i += NTHR) wba[i] = wmi[(size_t)(i >> 3) * DIN + 2816 + (i & 7)];
        __syncthreads();
    }
    const int gw = blockIdx.x * NWAVES + wave, NGW = gridDim.x * NWAVES;
    for (int rg = gw; rg < M / 8; rg += NGW) {
        const int b = (rg * 8) >> 11;
        f32x4 gp[4], sh[4];
#pragma unroll
        for (int j = 0; j < 4; ++j) { const int col = 256 * j + 4 * lane;
            const f32x4 g = *(const f32x4*)(gain + col), s = *(const f32x4*)(scalep + (size_t)b * NMODC + col);
            gp[j] = g * (1.0f + s); sh[j] = *(const f32x4*)(shiftp + (size_t)b * NMODC + col); }
        for (int i = 0; i < 8; ++i) {
            const int m = rg * 8 + i;
            f32x4 v[4]; float ss = 0.f;
#pragma unroll
            for (int j = 0; j < 4; ++j) { v[j] = *(const f32x4*)(X + (size_t)m * D + 256 * j + 4 * lane); ss += (v[j].x * v[j].x + v[j].y * v[j].y) + (v[j].z * v[j].z + v[j].w * v[j].w); }
            const float rstd = __builtin_amdgcn_rsqf(wave_sum_fast(ss) * (1.0f / D) + EPS);
#pragma unroll
            for (int j = 0; j < 4; ++j) { v[j] = v[j] * rstd * gp[j] + sh[j];
                u32x2 o; o.x = pk2(v[j].x, v[j].y); o.y = pk2(v[j].z, v[j].w);
                *(u32x2*)(H + (size_t)m * D + 256 * j + 4 * lane) = o; }
            if (WITH_BA) {
                float acc[8];
#pragma unroll
                for (int q = 0; q < 8; ++q) acc[q] = 0.f;
#pragma unroll
                for (int j = 0; j < 4; ++j)
#pragma unroll
                    for (int e = 0; e < 4; ++e) { const int k = 256 * j + 4 * lane + e; const f32x4 w0 = *(const LAS f32x4*)(wba + k * 8), w1 = *(const LAS f32x4*)(wba + k * 8 + 4); const float hv = v[j][e];
                        acc[0] += hv * w0.x; acc[1] += hv * w0.y; acc[2] += hv * w0.z; acc[3] += hv * w0.w; acc[4] += hv * w1.x; acc[5] += hv * w1.y; acc[6] += hv * w1.z; acc[7] += hv * w1.w; }
#pragma unroll
                for (int q = 0; q < 8; ++q) acc[q] = wave_sum(acc[q]);
                if (lane == 0) { *(f32x4*)(BAout + (size_t)m * 8) = (f32x4){acc[0], acc[1], acc[2], acc[3]}; *(f32x4*)(BAout + (size_t)m * 8 + 4) = (f32x4){acc[4], acc[5], acc[6], acc[7]}; }
            }
        }
    }
    if (WITH_BA) __syncthreads();
}

__device__ __forceinline__ void phase_final(float* X, const float* gain) {
    const int tid_ = tid_l(); const int wave = __builtin_amdgcn_readfirstlane(tid_ >> 6), lane = tid_ & 63;
    const int gw = blockIdx.x * NWAVES + wave, NGW = gridDim.x * NWAVES;
    f32x4 g[4];
#pragma unroll
    for (int j = 0; j < 4; ++j) g[j] = *(const f32x4*)(gain + 256 * j + 4 * lane);
    for (int m = gw; m < M; m += NGW) {
        f32x4 v[4]; float ss = 0.f;
#pragma unroll
        for (int j = 0; j < 4; ++j) { v[j] = *(const f32x4*)(X + (size_t)m * D + 256 * j + 4 * lane); ss += (v[j].x * v[j].x + v[j].y * v[j].y) + (v[j].z * v[j].z + v[j].w * v[j].w); }
        const float rstd = __builtin_amdgcn_rsqf(wave_sum_fast(ss) * (1.0f / D) + EPS);
#pragma unroll
        for (int j = 0; j < 4; ++j) *(f32x4*)(X + (size_t)m * D + 256 * j + 4 * lane) = v[j] * rstd * g[j];
    }
}

#define LDS_BARRIER() do { asm volatile("s_waitcnt lgkmcnt(0)" ::: "memory"); __builtin_amdgcn_s_barrier(); asm volatile("" ::: "memory"); } while (0)
typedef short bf16x8_t __attribute__((ext_vector_type(8)));
__device__ __forceinline__ void phase_prep(const Params& p, int l, LAS unsigned char* lds) {
    const int tid_ = tid_l(); const int wave = __builtin_amdgcn_readfirstlane(tid_ >> 6), lane = tid_ & 63;
    const int gw = blockIdx.x * NWAVES + wave, NGW = gridDim.x * NWAVES;
    const bf16* PROJ = (const bf16*)(p.ws + WS_PROJ); const float* BA = (const float*)(p.ws + WS_BA);
    {
        LAS bf16* tile = (LAS bf16*)(lds + wave * 16384); bf16* VT = (bf16*)(p.ws + WS_VT);
        for (int item = gw; item < 1024; item += NGW) {
            const int bh = item >> 5, tb = item & 31, b = bh >> 2, h = bh & 3; const size_t mt = (size_t)b * SEQ + tb * 64;
#pragma unroll
            for (int r0 = 0; r0 < 64; r0 += 16) { unsigned tv[16];
#pragma unroll
                for (int r = 0; r < 16; ++r) tv[r] = PROJ[(mt + r0 + r) * NPROJ + PC_SBV + h * 64 + lane];
#pragma unroll
                for (int r = 0; r < 16; ++r) tile[(r0 + r) * 66 + lane] = (bf16)tv[r]; }
            asm volatile("s_waitcnt lgkmcnt(0)" ::: "memory");
#pragma unroll 16
            for (int d = 0; d < 64; ++d) VT[((size_t)bh * 64 + d) * SEQ + tb * 64 + lane] = tile[lane * 66 + d];
            asm volatile("s_waitcnt lgkmcnt(0)" ::: "memory");
        }
        __syncthreads();
    }
    bf16* QD = (bf16*)(p.ws + WS_QD); bf16* Wg = (bf16*)(p.ws + WS_W); bf16* Ug = (bf16*)(p.ws + WS_U);
    bf16* KDT = (bf16*)(p.ws + WS_KDT); bf16* AQK = (bf16*)(p.ws + WS_AQK); float* CD = (float*)(p.ws + WS_CD);
    const float* cw = p.in[7] + (size_t)l * 4 * 1536; const float* A_log = p.in[8] + l * 4; const float* dtb = p.in[9] + l * 4;
    LAS bf16* Kb = (LAS bf16*)lds; LAS bf16* Qb = Kb + 64 * 136; LAS bf16* Vb = Qb + 64 * 136;
    LAS float* Akk = (LAS float*)(lds + 3 * 17408);
    LAS float* s_la = Akk + 64 * 68; LAS float* s_beta = s_la + 64; LAS float* s_g = s_beta + 64; LAS float* s_eg = s_g + 64;
    const int g = lane >> 4, c = lane & 15;
    for (int unit = blockIdx.x; unit < 1024; unit += gridDim.x) {
        const int bh = unit >> 5, n = unit & 31, b = bh >> 2, h = bh & 3; const size_t m0 = (size_t)b * SEQ + n * 64;
        const int cq = h * 128 + 2 * lane;
        f32x2 cwq[4], cwk[4], cwv[4];
#pragma unroll
        for (int j = 0; j < 4; ++j) { cwq[j] = *(const f32x2*)(cw + j * 1536 + cq); cwk[j] = *(const f32x2*)(cw + j * 1536 + 512 + cq); cwv[j] = *(const f32x2*)(cw + j * 1536 + 1024 + cq); }
        unsigned xq[11], xk[11], xv[11];
#pragma unroll
        for (int rr = 0; rr < 11; ++rr) { const int r_ = wave * 8 - 3 + rr;
            if (n * 64 + r_ >= 0) { const bf16* row = PROJ + (size_t)((long)m0 + r_) * NPROJ + PC_GQ + cq; xq[rr] = *(const unsigned*)row; xk[rr] = *(const unsigned*)(row + 512); xv[rr] = *(const unsigned*)(row + 1024); }
            else { xq[rr] = 0u; xk[rr] = 0u; xv[rr] = 0u; } }
#pragma unroll
        for (int i = 0; i < 8; ++i) {
            const int r = wave * 8 + i; const size_t m = m0 + r;
            float q0 = 0.f, q1 = 0.f, k0 = 0.f, k1 = 0.f, v0 = 0.f, v1 = 0.f;
#pragma unroll
            for (int j = 0; j < 4; ++j) { const unsigned uq = xq[i + j], uk = xk[i + j], uv = xv[i + j];
                q0 += cwq[j].x * bflo(uq); q1 += cwq[j].y * bfhi(uq); k0 += cwk[j].x * bflo(uk); k1 += cwk[j].y * bfhi(uk); v0 += cwv[j].x * bflo(uv); v1 += cwv[j].y * bfhi(uv); }
            q0 = silu(q0); q1 = silu(q1); k0 = silu(k0); k1 = silu(k1); v0 = silu(v0); v1 = silu(v1);
            const float sq = wave_sum_fast(q0 * q0 + q1 * q1), sk = wave_sum_fast(k0 * k0 + k1 * k1);
            const float rq = (__builtin_amdgcn_rsqf(sq + EPS)) * 0.08838834764831845f, rk = __builtin_amdgcn_rsqf(sk + EPS);
            *(LAS unsigned*)(Qb + r * 136 + 2 * lane) = pk2(q0 * rq, q1 * rq); *(LAS unsigned*)(Kb + r * 136 + 2 * lane) = pk2(k0 * rk, k1 * rk); *(LAS unsigned*)(Vb + r * 136 + 2 * lane) = pk2(v0, v1);
            if (lane == 0) {
                s_beta[r] = 1.0f / (1.0f + expf(-BA[m * 8 + h]));
                s_la[r] = -expf(A_log[h]) * softplus_precise(BA[m * 8 + 4 + h] + dtb[h]);
            }
        }
        LDS_BARRIER();
        if (wave == 0) { float x = s_la[lane];
#pragma unroll
            for (int o = 1; o < 64; o <<= 1) { const float tmp = __shfl_up(x, o); if (lane >= o) x += tmp; }
            s_g[lane] = x; s_eg[lane] = expf(x); }
        LDS_BARRIER();
        for (int q = 0; q < 4; ++q) {
            const int idx = wave * 4 + q; const bool isQK = idx >= 16; const int ti = (idx >> 2) & 3, tj = idx & 3;
            f32x4 acc = (f32x4){0.f, 0.f, 0.f, 0.f};
            if (tj <= ti) {
                const LAS bf16* X = isQK ? Qb : Kb;
#pragma unroll
                for (int ks = 0; ks < 4; ++ks) { const bf16x8_t a = *(const LAS bf16x8_t*)(X + (16 * ti + c) * 136 + 32 * ks + 8 * g), bb = *(const LAS bf16x8_t*)(Kb + (16 * tj + c) * 136 + 32 * ks + 8 * g);
                    acc = __builtin_amdgcn_mfma_f32_16x16x32_bf16(a, bb, acc, 0, 0, 0); }
            }
#pragma unroll
            for (int i = 0; i < 4; ++i) { const int row = 16 * ti + 4 * g + i, col = 16 * tj + c;
                const float dec = (col <= row) ? __expf(s_g[row] - s_g[col]) : 0.f;
                if (isQK) AQK[((size_t)unit * 64 + row) * 64 + col] = (bf16)f2bf(dec * acc[i]);
                else Akk[col * 68 + row] = (col < row) ? s_beta[row] * dec * acc[i] : 0.f; }
        }
        LDS_BARRIER();
        if (wave < 4) {
            const bool isW = wave >= 2; const int col = tid_ & 127;
            const LAS bf16* src = isW ? Kb : Vb; bf16* dst = (isW ? Wg : Ug) + m0 * 512 + h * 128 + col;
            float X[64];
            int lz; asm volatile("v_mov_b32 %0, 0" : "=v"(lz));
            const LAS float* Ak = Akk + lz; const LAS float* sb_ = s_beta + lz; const LAS float* se_ = s_eg + lz;
#pragma unroll
            for (int i = 0; i < 64; ++i) { X[i] = sb_[i] * (isW ? se_[i] : 1.0f) * __uint_as_float((unsigned)src[i * 136 + col] << 16);
                if ((i & 7) == 7) asm volatile("" : "+v"(X[i - 7]), "+v"(X[i - 6]), "+v"(X[i - 5]), "+v"(X[i - 4]), "+v"(X[i - 3]), "+v"(X[i - 2]), "+v"(X[i - 1]), "+v"(X[i]) :: "memory"); }
#pragma unroll
            for (int j = 0; j < 63; ++j) {
                f32x4 arow[16];
#pragma unroll
                for (int i4 = (j >> 2) << 2; i4 < 64; i4 += 4) arow[i4 >> 2] = *(const LAS f32x4*)(Ak + j * 68 + i4);
                const float xj = X[j];
                *dst = (bf16)f2bf(xj); dst += 512; asm volatile("" : "+v"(dst));
                asm volatile("s_waitcnt lgkmcnt(0)" ::: "memory");
#pragma unroll
                for (int i4 = (j >> 2) << 2; i4 < 64; i4 += 4) { const f32x4 a = arow[i4 >> 2];
                    X[i4] -= a.x * xj; X[i4 + 1] -= a.y * xj; X[i4 + 2] -= a.z * xj; X[i4 + 3] -= a.w * xj; }
            }
            *dst = (bf16)f2bf(X[63]);
        } else {
            const int t2 = tid_ - 256;
            for (int idx = t2; idx < 64 * 64; idx += 256) { const int r = idx >> 6, dp = idx & 63; const unsigned u = *(const LAS unsigned*)(Qb + r * 136 + 2 * dp); const float e = s_eg[r];
                *(unsigned*)(QD + (m0 + r) * 512 + h * 128 + 2 * dp) = pk2(bflo(u) * e, bfhi(u) * e); }
            const int cc = t2 & 63; const float kd = __expf(s_g[63] - s_g[cc]);
            for (int d = t2 >> 6; d < 128; d += 4) KDT[((size_t)unit * 128 + d) * 64 + cc] = (bf16)f2bf(__uint_as_float((unsigned)Kb[cc * 136 + d] << 16) * kd);
            if (t2 == 0) CD[unit] = s_eg[63];
        }
        LDS_BARRIER();
    }
}

template <bool DUMMY>
__device__ __forceinline__ void gdn_scan_block(const Params& p, int l, int unit, LAS unsigned char* lds) {
    const int tid_ = tid_l(); const int w = __builtin_amdgcn_readfirstlane(tid_ >> 6), lane = tid_ & 63, g = lane >> 4, c = lane & 15;
    const int bh = unit >> 1, eh = unit & 1, b = bh >> 2, h = bh & 3, te = w & 3, rh = w >> 2;
    LAS bf16* ST = (LAS bf16*)lds; LAS bf16* Wb = ST + 64 * 136; LAS bf16* QDb = Wb + 64 * 136; LAS bf16* KDTb = QDb + 64 * 136;
    LAS bf16* AQb = KDTb + 128 * 72; LAS bf16* vnT = AQb + 64 * 72 + w * (16 * 72); LAS bf16* Ub = AQb + 64 * 72 + 8 * 16 * 72;
    const bf16* QD = (const bf16*)(p.ws + WS_QD); const bf16* Wg = (const bf16*)(p.ws + WS_W); const bf16* Ug = (const bf16*)(p.ws + WS_U);
    const bf16* KDT = (const bf16*)(p.ws + WS_KDT); const bf16* AQK = (const bf16*)(p.ws + WS_AQK); const float* CD = (const float*)(p.ws + WS_CD);
    bf16* Uraw = (bf16*)(p.ws + (DUMMY ? WS_KDT : WS_U));
    for (int i = tid_; i < 64 * 136 / 2; i += NTHR) ((LAS unsigned*)ST)[i] = 0u;
    f32x4 S[4];
#pragma unroll
    for (int j = 0; j < 4; ++j) S[j] = (f32x4){0.f, 0.f, 0.f, 0.f};
    u32x4 rW[2], rQ[2], rK[2], rA, rU; float cdn;
#define GDN_FETCH(n_) do { const size_t m0_ = (size_t)b * SEQ + (n_) * 64; const size_t unit_ = (size_t)bh * 32 + (n_); \
        _Pragma("unroll") for (int k_ = 0; k_ < 2; ++k_) { const int idx_ = tid_ + NTHR * k_; const size_t go_ = (m0_ + (idx_ >> 4)) * 512 + h * 128 + 8 * (idx_ & 15); \
            rW[k_] = *(const u32x4*)(Wg + go_); rQ[k_] = *(const u32x4*)(QD + go_); \
            rK[k_] = *(const u32x4*)(KDT + (unit_ * 128 + (idx_ >> 3)) * 64 + 8 * (idx_ & 7)); } \
        rU = *(const u32x4*)(Ug + (m0_ + (tid_ >> 3)) * 512 + h * 128 + 64 * eh + 8 * (tid_ & 7)); \
        rA = *(const u32x4*)(AQK + (unit_ * 64 + (tid_ >> 3)) * 64 + 8 * (tid_ & 7)); cdn = CD[unit_]; } while (0)
#define LDSFENCE() asm volatile("s_waitcnt lgkmcnt(0)" ::: "memory")
    GDN_FETCH(0);
    for (int n = 0; n < 32; ++n) {
        const size_t m0 = (size_t)b * SEQ + n * 64;
#pragma unroll
        for (int k = 0; k < 2; ++k) { const int idx = tid_ + NTHR * k; const int lo = (idx >> 4) * 136 + 8 * (idx & 15);
            *(LAS u32x4*)(Wb + lo) = rW[k]; *(LAS u32x4*)(QDb + lo) = rQ[k];
            *(LAS u32x4*)(KDTb + (idx >> 3) * 72 + 8 * (idx & 7)) = rK[k]; }
        *(LAS u32x4*)(Ub + (tid_ >> 3) * 72 + 8 * (tid_ & 7)) = rU;
        *(LAS u32x4*)(AQb + (tid_ >> 3) * 72 + 8 * (tid_ & 7)) = rA;
        const float cd = cdn;
        LDS_BARRIER();
        if (n + 1 < 32) GDN_FETCH(n + 1);
        bf16x8_t stf[4], af[4][4];
#pragma unroll
        for (int ks = 0; ks < 4; ++ks) stf[ks] = *(const LAS bf16x8_t*)(ST + (16 * te + c) * 136 + 32 * ks + 8 * g);
#pragma unroll
        for (int tc = 0; tc < 4; ++tc)
#pragma unroll
            for (int ks = 0; ks < 4; ++ks) af[tc][ks] = *(const LAS bf16x8_t*)(Wb + (16 * tc + c) * 136 + 32 * ks + 8 * g);
        float uv[4][4];
#pragma unroll
        for (int tc = 0; tc < 4; ++tc)
#pragma unroll
            for (int i = 0; i < 4; ++i) uv[tc][i] = __uint_as_float((unsigned)Ub[(16 * tc + 4 * g + i) * 72 + 16 * te + c] << 16);
        LDSFENCE();
#pragma unroll
        for (int tc = 0; tc < 4; ++tc) {
            f32x4 acc = (f32x4){0.f, 0.f, 0.f, 0.f};
#pragma unroll
            for (int ks = 0; ks < 4; ++ks) acc = __builtin_amdgcn_mfma_f32_16x16x32_bf16(af[tc][ks], stf[ks], acc, 0, 0, 0);
            u32x2 o; o.x = pk2(uv[tc][0] - acc[0], uv[tc][1] - acc[1]); o.y = pk2(uv[tc][2] - acc[2], uv[tc][3] - acc[3]);
            *(LAS u32x2*)(vnT + c * 72 + 16 * tc + 4 * g) = o;
        }
        bf16x8_t vf[2], qf[2][2];
#pragma unroll
        for (int t2 = 0; t2 < 2; ++t2)
#pragma unroll
            for (int ks = 0; ks < 4; ++ks) af[t2][ks] = *(const LAS bf16x8_t*)(QDb + (16 * (2 * rh + t2) + c) * 136 + 32 * ks + 8 * g);
#pragma unroll
        for (int t2 = 0; t2 < 2; ++t2)
#pragma unroll
            for (int ks = 0; ks < 2; ++ks) qf[t2][ks] = *(const LAS bf16x8_t*)(AQb + (16 * (2 * rh + t2) + c) * 72 + 32 * ks + 8 * g);
#pragma unroll
        for (int ks = 0; ks < 2; ++ks) vf[ks] = *(const LAS bf16x8_t*)(vnT + c * 72 + 32 * ks + 8 * g);
        LDSFENCE();
        f32x4 ot[2];
#pragma unroll
        for (int t2 = 0; t2 < 2; ++t2) {
            f32x4 acc = (f32x4){0.f, 0.f, 0.f, 0.f};
#pragma unroll
            for (int ks = 0; ks < 4; ++ks) acc = __builtin_amdgcn_mfma_f32_16x16x32_bf16(af[t2][ks], stf[ks], acc, 0, 0, 0);
#pragma unroll
            for (int ks = 0; ks < 2; ++ks) acc = __builtin_amdgcn_mfma_f32_16x16x32_bf16(qf[t2][ks], vf[ks], acc, 0, 0, 0);
            ot[t2] = acc;
        }
#pragma unroll
        for (int t2 = 0; t2 < 2; ++t2)
#pragma unroll
            for (int i = 0; i < 4; ++i) Uraw[(m0 + 16 * (2 * rh + t2) + 4 * g + i) * 512 + h * 128 + 64 * eh + 16 * te + c] = (bf16)f2bf(ot[t2][i]);
        bf16x8_t kf[4][2];
#pragma unroll
        for (int j = 0; j < 4; ++j)
#pragma unroll
            for (int ks = 0; ks < 2; ++ks) kf[j][ks] = *(const LAS bf16x8_t*)(KDTb + (16 * (4 * rh + j) + c) * 72 + 32 * ks + 8 * g);
        LDSFENCE();
#pragma unroll
        for (int j = 0; j < 4; ++j) {
            f32x4 acc = S[j] * cd;
#pragma unroll
            for (int ks = 0; ks < 2; ++ks) acc = __builtin_amdgcn_mfma_f32_16x16x32_bf16(kf[j][ks], vf[ks], acc, 0, 0, 0);
            S[j] = acc;
        }
        LDS_BARRIER();
#pragma unroll
        for (int j = 0; j < 4; ++j) { u32x2 o; o.x = pk2(S[j][0], S[j][1]); o.y = pk2(S[j][2], S[j][3]);
            *(LAS u32x2*)(ST + (16 * te + c) * 136 + 16 * (4 * rh + j) + 4 * g) = o; }
        LDS_BARRIER();
    }
#undef LDSFENCE
#undef GDN_FETCH
}

__device__ __forceinline__ void hgrn_scan_block(const Params& p, int l, int unit, LAS unsigned char* lds) {
    const int tid_ = tid_l(); const int w = __builtin_amdgcn_readfirstlane(tid_ >> 6), lane = tid_ & 63, tt = (lane >> 1) & 15, dd = lane & 1;
    const int bh = unit >> 2, dq = unit & 3, b = bh >> 2, h = bh & 3; const size_t m0 = (size_t)b * SEQ;
    LAS float* coef = (LAS float*)lds + w * (16 * 8);
    LAS float* part = (LAS float*)(lds + 4096);
    LAS bf16* vst = (LAS bf16*)(lds + 4096 + 65536);
    LAS bf16* qst = vst + 2 * 128 * 64;
    LAS bf16* fst = qst + 2 * 128 * 16;
    const bf16* PROJ = (const bf16*)(p.ws + WS_PROJ);
    bf16* OUT = dq == 0 ? (bf16*)(p.ws + WS_H) + m0 * D + 768 + h * 64 + lane
              : (dq == 3 ? (bf16*)(p.ws + WS_P3) : (bf16*)(p.ws + WS_OMIX) + (size_t)(dq - 1) * M * 256) + m0 * 256 + h * 64 + lane;
    const int opitch = dq ? 256 : D;
    const int dcol = h * 64 + 16 * dq + 2 * w + dd;
    float lb = 0.f;
    if (l == 1) lb = 1.0f / (1.0f + expf(p.in[13][dcol] - p.in[13][256 + dcol]));
    f32x2 S2 = (f32x2){0.f, 0.f};
    u32x4 rv[2], rq;
    const bf16* gq = PROJ + m0 * NPROJ + (tid_ < 256 ? PC_HQ : PC_HF) + h * 64 + 16 * dq + 8 * (tid_ & 1);
#define HG_FETCH(sg_) do { const size_t t0_ = (size_t)(sg_) * 128; \
        _Pragma("unroll") for (int k_ = 0; k_ < 2; ++k_) { const int idx_ = tid_ + NTHR * k_; rv[k_] = *(const u32x4*)(PROJ + (m0 + t0_ + (idx_ >> 3)) * NPROJ + PC_HI + h * 64 + 8 * (idx_ & 7)); } \
        rq = *(const u32x4*)(gq + (t0_ + ((tid_ & 255) >> 1)) * NPROJ); } while (0)
#define HG_STAGE(sb_) do { \
        _Pragma("unroll") for (int k_ = 0; k_ < 2; ++k_) { const int idx_ = tid_ + NTHR * k_; *(LAS u32x4*)(vst + (sb_) * 128 * 64 + (idx_ >> 3) * 64 + 8 * (idx_ & 7)) = rv[k_]; } \
        *(LAS u32x4*)((tid_ < 256 ? qst : fst) + (sb_) * 128 * 16 + ((tid_ & 255) >> 1) * 16 + 8 * (tid_ & 1)) = rq; } while (0)
    unsigned ypend[2] = {0u, 0u};
    HG_FETCH(0);
    HG_STAGE(0);
    LDS_BARRIER();
    for (int sg = 0; sg < SEQ / 128; ++sg) {
        const int sb = sg & 1;
        if (sg + 1 < SEQ / 128) HG_FETCH(sg + 1);
        for (int g8 = 0; g8 < 8; ++g8) {
            const int grp = sg * 8 + g8, buf = grp & 1, r0 = g8 * 16;
            if (grp > 0) {
#pragma unroll
                for (int k = 0; k < 2; ++k) OUT[(size_t)((grp - 1) * 16 + 2 * w + k) * opitch] = (bf16)ypend[k];
            }
            {   const float hq = __uint_as_float((unsigned)qst[sb * 128 * 16 + (r0 + tt) * 16 + 2 * w + dd] << 16), fp = __uint_as_float((unsigned)fst[sb * 128 * 16 + (r0 + tt) * 16 + 2 * w + dd] << 16);
                const float en = __expf(-fabsf(fp)), rd = __builtin_amdgcn_rcpf(1.0f + en), sg_ = fp >= 0.f ? rd : en * rd, sn = fp >= 0.f ? en * rd : rd;
                LAS float* cr = coef + tt * 8 + dd;
                if (lane < 32) { cr[0] = lb + (1.0f - lb) * sg_; cr[2] = (1.0f - lb) * sn; cr[4] = silu(hq); } }
            unsigned vraw[16];
#pragma unroll
            for (int s = 0; s < 16; ++s) vraw[s] = vst[sb * 128 * 64 + (r0 + s) * 64 + lane];
            float pacc[16];
            f32x4 ca[16]; f32x2 cb[16];
#pragma unroll
            for (int s = 0; s < 16; ++s) { ca[s] = ((const LAS f32x4*)(coef + s * 8))[0]; cb[s] = ((const LAS f32x2*)(coef + s * 8))[2]; }
#pragma unroll
            for (int s = 0; s < 16; ++s) {
                const float vv = __uint_as_float(vraw[s] << 16); const f32x2 v2 = (f32x2){vv, vv};
                S2 = S2 * (f32x2){ca[s].x, ca[s].y} + (f32x2){ca[s].z, ca[s].w} * v2;
                const f32x2 p2 = cb[s] * S2;
                pacc[s] = p2.x + p2.y;
            }
#pragma unroll
            for (int s = 0; s < 16; ++s) part[((buf * 8 + w) * 16 + s) * 64 + lane] = pacc[s];
            LDS_BARRIER();
#pragma unroll
            for (int k = 0; k < 2; ++k) { const int s = 2 * w + k; float o = 0.f;
#pragma unroll
                for (int ww = 0; ww < 8; ++ww) o += part[((buf * 8 + ww) * 16 + s) * 64 + lane];
                ypend[k] = f2bf(o); }
        }
        if (sg + 1 < SEQ / 128) { HG_STAGE(sb ^ 1); LDS_BARRIER(); }
    }
#pragma unroll
    for (int k = 0; k < 2; ++k) OUT[(size_t)((SEQ / 16 - 1) * 16 + 2 * w + k) * opitch] = (bf16)ypend[k];
#undef HG_STAGE
#undef HG_FETCH
}

__device__ __forceinline__ void sb_tile_wave(const Params& p, int l, int task, int lane) {
    const bf16* PROJ = (const bf16*)(p.ws + WS_PROJ); const bf16* VT = (const bf16*)(p.ws + WS_VT); bf16* O = (bf16*)(p.ws + WS_H);
    const int bh = task >> 7, qt = task & 127, b = bh >> 2, h = bh & 3, t0 = qt * 16, g = lane >> 4, c = lane & 15;
    const size_t mb = (size_t)b * SEQ;
    bf16x8_t qfrag[2];
#pragma unroll
    for (int ks = 0; ks < 2; ++ks) qfrag[ks] = *(const bf16x8_t*)(PROJ + (mb + t0 + c) * NPROJ + PC_SBQ + h * 64 + 32 * ks + 8 * g);
    f32x4 oacc[4];
#pragma unroll
    for (int dt = 0; dt < 4; ++dt) oacc[dt] = (f32x4){0.f, 0.f, 0.f, 0.f};
    float carry = 0.f;
    const int tq = t0 + c;
    for (int kb = (t0 + 14) >> 5; kb >= 0; --kb) {
        const int k0 = 32 * kb;
        float w[2][4];
#pragma unroll
        for (int jj = 0; jj < 2; ++jj) {
            const int j = 1 - jj;
            f32x4 acc = (f32x4){0.f, 0.f, 0.f, 0.f};
#pragma unroll
            for (int ks = 0; ks < 2; ++ks) { const bf16x8_t kf = *(const bf16x8_t*)(PROJ + (mb + k0 + 16 * j + c) * NPROJ + PC_SBK + h * 64 + 32 * ks + 8 * g);
                acc = __builtin_amdgcn_mfma_f32_16x16x32_bf16(kf, qfrag[ks], acc, 0, 0, 0); }
            float lk[4], ls[4]; bool valid[4];
#pragma unroll
            for (int i = 0; i < 4; ++i) { const float z = acc[i] * 0.125f; valid[i] = (k0 + 16 * j + 4 * g + i) < tq;
                const float sp = fmaxf(z, 0.f) + __logf(1.0f + __expf(-fabsf(z))); lk[i] = valid[i] ? -sp : 0.f; ls[i] = z - sp; }
            const float suf2 = lk[3], suf1 = lk[3] + lk[2], suf0 = suf1 + lk[1], T = suf0 + lk[0];
            const float T1 = __shfl_down(T, 16), T2 = __shfl_down(T, 32), T3 = __shfl_down(T, 48);
            const float E = (g < 3 ? T1 : 0.f) + (g < 2 ? T2 : 0.f) + (g < 1 ? T3 : 0.f);
            const float Ttot = __shfl(T + E, c);
            const float base = carry + E;
            w[j][0] = valid[0] ? __expf(ls[0] + base + suf0) : 0.f; w[j][1] = valid[1] ? __expf(ls[1] + base + suf1) : 0.f;
            w[j][2] = valid[2] ? __expf(ls[2] + base + suf2) : 0.f; w[j][3] = valid[3] ? __expf(ls[3] + base) : 0.f;
            carry += Ttot;
        }
        u32x4 pu; pu.x = pk2(w[0][0], w[0][1]); pu.y = pk2(w[0][2], w[0][3]); pu.z = pk2(w[1][0], w[1][1]); pu.w = pk2(w[1][2], w[1][3]);
        const bf16x8_t pfrag = __builtin_bit_cast(bf16x8_t, pu);
#pragma unroll
        for (int dt = 0; dt < 4; ++dt) { const bf16* vr = VT + ((size_t)bh * 64 + 16 * dt + c) * SEQ + k0 + 4 * g;
            const u32x2 v0 = *(const u32x2*)vr, v1 = *(const u32x2*)(vr + 16);
            u32x4 vu; vu.x = v0.x; vu.y = v0.y; vu.z = v1.x; vu.w = v1.y;
            oacc[dt] = __builtin_amdgcn_mfma_f32_16x16x32_bf16(__builtin_bit_cast(bf16x8_t, vu), pfrag, oacc[dt], 0, 0, 0); }
        if (__all(carry < -90.0f)) break;
    }
    float ss = 0.f;
#pragma unroll
    for (int dt = 0; dt < 4; ++dt) ss += (oacc[dt][0] * oacc[dt][0] + oacc[dt][1] * oacc[dt][1]) + (oacc[dt][2] * oacc[dt][2] + oacc[dt][3] * oacc[dt][3]);
    ss += __shfl_xor(ss, 16); ss += __shfl_xor(ss, 32);
    const float r = __builtin_amdgcn_rsqf(ss * (1.0f / 64.0f) + EPS);
#pragma unroll
    for (int dt = 0; dt < 4; ++dt) { const f32x4 gn = *(const f32x4*)(p.in[10] + l * 64 + 16 * dt + 4 * g);
        u32x2 o; o.x = pk2(oacc[dt][0] * r * gn.x, oacc[dt][1] * r * gn.y); o.y = pk2(oacc[dt][2] * r * gn.z, oacc[dt][3] * r * gn.w);
        *(u32x2*)(O + (mb + tq) * D + h * 64 + 16 * dt + 4 * g) = o; }
}

__device__ __forceinline__ void phase_scan(const Params& p, int l, LAS unsigned char* lds) {
    if (blockIdx.x < 64) { gdn_scan_block<false>(p, l, blockIdx.x, lds);
#if PROBE == 4
        gdn_scan_block<true>(p, l, blockIdx.x, lds);
#endif
    } else if (blockIdx.x < 192) { hgrn_scan_block(p, l, blockIdx.x - 64, lds);
#if PROBE == 5
        LDS_BARRIER(); hgrn_scan_block(p, l, blockIdx.x - 64, lds);
#endif
    }
    const int tid_ = tid_l(); const int lane = tid_ & 63;
    unsigned* ctr = (unsigned*)(p.ws + WS_TASK) + 64 * l;
    for (;;) {
        unsigned t = 0u;
        if (lane == 0) t = __hip_atomic_fetch_add(ctr, 1u, __ATOMIC_RELAXED, __HIP_MEMORY_SCOPE_AGENT);
        const int task = __builtin_amdgcn_readfirstlane((int)t);
        if (task >= 4096) break;
        sb_tile_wave(p, l, task, lane);
#if PROBE == 6
        sb_tile_wave(p, l, task, lane);
#endif
    }
}

__device__ __forceinline__ void phase_post(const Params& p, int l) {
    const int tid_ = tid_l(); const int wave = __builtin_amdgcn_readfirstlane(tid_ >> 6), lane = tid_ & 63;
    const int gw = blockIdx.x * NWAVES + wave, NGW = gridDim.x * NWAVES;
    const bf16* PROJ = (const bf16*)(p.ws + WS_PROJ); const bf16* P1 = (const bf16*)(p.ws + WS_OMIX); const bf16* Uraw = (const bf16*)(p.ws + WS_U); bf16* O = (bf16*)(p.ws + WS_H);
    const f32x2 gg = *(const f32x2*)(p.in[11] + l * 128 + 2 * lane);
    const f32x4 hg = *(const f32x4*)(p.in[12] + l * 64 + ((4 * lane) & 63));
    for (int m = gw; m < M; m += NGW) {
        unsigned uo[4], uz[4];
#pragma unroll
        for (int h = 0; h < 4; ++h) { uo[h] = *(const unsigned*)(Uraw + (size_t)m * 512 + h * 128 + 2 * lane); uz[h] = *(const unsigned*)(PROJ + (size_t)m * NPROJ + PC_GZ + h * 128 + 2 * lane); }
        const u32x2 a0 = *(const u32x2*)(O + (size_t)m * D + 768 + 4 * lane), a1 = *(const u32x2*)(P1 + (size_t)m * 256 + 4 * lane), a2 = *(const u32x2*)(P1 + ((size_t)M + m) * 256 + 4 * lane), a3 = *(const u32x2*)((const bf16*)(p.ws + WS_P3) + (size_t)m * 256 + 4 * lane), ug = *(const u32x2*)(PROJ + (size_t)m * NPROJ + PC_HG + 4 * lane);
#pragma unroll
        for (int h = 0; h < 4; ++h) { const float o0 = bflo(uo[h]), o1 = bfhi(uo[h]);
            const float r = __builtin_amdgcn_rsqf(wave_sum_fast(o0 * o0 + o1 * o1) * (1.0f / 128.0f) + EPS);
            *(unsigned*)(O + (size_t)m * D + 256 + h * 128 + 2 * lane) = pk2(o0 * r * gg.x * silu(bflo(uz[h])), o1 * r * gg.y * silu(bfhi(uz[h]))); }
        const float x0 = (bflo(a0.x) + bflo(a1.x)) + (bflo(a2.x) + bflo(a3.x)), x1 = (bfhi(a0.x) + bfhi(a1.x)) + (bfhi(a2.x) + bfhi(a3.x)), x2 = (bflo(a0.y) + bflo(a1.y)) + (bflo(a2.y) + bflo(a3.y)), x3 = (bfhi(a0.y) + bfhi(a1.y)) + (bfhi(a2.y) + bfhi(a3.y));
        float ss = (x0 * x0 + x1 * x1) + (x2 * x2 + x3 * x3);
        ss += dpp_mov<0xB1>(ss); ss += dpp_mov<0x4E>(ss); ss += dpp_mov<0x141>(ss); ss += dpp_mov<0x140>(ss);
        const float r = __builtin_amdgcn_rsqf(ss * (1.0f / 64.0f) + EPS);
        u32x2 wv; wv.x = pk2(x0 * r * hg.x * silu(bflo(ug.x)), x1 * r * hg.y * silu(bfhi(ug.x))); wv.y = pk2(x2 * r * hg.z * silu(bflo(ug.y)), x3 * r * hg.w * silu(bfhi(ug.y)));
        *(u32x2*)(O + (size_t)m * D + 768 + 4 * lane) = wv;
    }
}

#define RLX_AGENT __ATOMIC_RELAXED, __HIP_MEMORY_SCOPE_AGENT
#define XB_TMO      128
#define XB_XCNT(j)  (256  + 64 * (j))
#define XB_XSUB(j)  (1280 + 64 * (j))
#define XB_XGEN(j)  (2304 + 64 * (j))
#define XB_TOP      3328
#define XB_TOPGEN   3392
#define XCD_BAR_WORDS 3456
#define XB_SPIN_CAP (1u << 18)

__device__ __forceinline__ unsigned xb_ld(unsigned* p)              { return __hip_atomic_load(p, __ATOMIC_RELAXED, __HIP_MEMORY_SCOPE_AGENT); }
__device__ __forceinline__ unsigned xb_add(unsigned* p, unsigned v) { return __hip_atomic_fetch_add(p, v, __ATOMIC_RELAXED, __HIP_MEMORY_SCOPE_AGENT); }
__device__ __forceinline__ unsigned xb_xcc_id() { return (unsigned)__builtin_amdgcn_s_getreg((3 << 11) | 20) & 0xFu; }
#define XB_SPIN(cond, bar) do { unsigned _sp = 0; while (cond) { __builtin_amdgcn_s_sleep(1); \
    if ((++_sp & 255u) == 0u) { if (xb_ld(&(bar)[XB_TMO])) break; if (_sp > XB_SPIN_CAP) { atomicAdd(&(bar)[XB_TMO], 1u); break; } } } } while (0)

struct XcdBarrier {
    unsigned* bar; unsigned x;
    volatile LAS unsigned* st;
};

__device__ __forceinline__ XcdBarrier xcd_barrier_post(unsigned* bar, volatile LAS unsigned* st) {
    XcdBarrier b; b.bar = bar; b.x = xb_xcc_id(); b.st = st;
    if (threadIdx.x == 0) (void)xb_add(&bar[XB_XCNT(b.x)], 1u);
    return b;
}
__device__ __forceinline__ void xcd_barrier_complete(unsigned* bar, unsigned x, unsigned& nloc, unsigned& nx) {
    const unsigned G = gridDim.x * gridDim.y * gridDim.z;
    unsigned sum, cnt, mine, sp = 0u;
    for (;;) {
        sum = 0u; cnt = 0u; mine = 0u;
#pragma unroll
        for (unsigned j = 0; j < 16; ++j) { const unsigned c = xb_ld(&bar[XB_XCNT(j)]); sum += c; cnt += (c > 0u) ? 1u : 0u; mine = (j == x) ? c : mine; }
        if (sum == G) break;
        __builtin_amdgcn_s_sleep(1);
        if ((++sp & 255u) == 0u) { if (xb_ld(&bar[XB_TMO])) break; if (sp > XB_SPIN_CAP) { atomicAdd(&bar[XB_TMO], 1u); break; } }
    }
    nloc = mine > 0u ? mine : 1u; nx = cnt > 0u ? cnt : 1u;
}

__device__ __forceinline__ void xcd_barrier(const XcdBarrier& b) {
    asm volatile("s_waitcnt vmcnt(0)" ::: "memory");
    __syncthreads();
    if (threadIdx.x == 0) {
        unsigned* bar = b.bar;
        __builtin_amdgcn_s_waitcnt(0);
        unsigned nloc = b.st[0], nx = b.st[1];
        if (nloc == 0u) { xcd_barrier_complete(bar, b.x, nloc, nx); b.st[0] = nloc; b.st[1] = nx; }
        const unsigned old = xb_add(&bar[XB_XSUB(b.x)], 1u);
        const unsigned gen = old / nloc;
        if (old + 1u == (gen + 1u) * nloc) {
            __builtin_amdgcn_fence(__ATOMIC_RELEASE, "agent");
            asm volatile("s_waitcnt vmcnt(0)" ::: "memory");
            const unsigned og = xb_add(&bar[XB_TOP], 1u);
            const unsigned tg = og / nx;
            if (og + 1u == (tg + 1u) * nx) xb_add(&bar[XB_TOPGEN], 1u);
            else XB_SPIN(xb_ld(&bar[XB_TOPGEN]) == tg, bar);
            __builtin_amdgcn_fence(__ATOMIC_ACQUIRE, "agent");
            xb_add(&bar[XB_XGEN(b.x)], 1u);
            asm volatile("s_waitcnt vmcnt(0)" ::: "memory");
        } else {
            XB_SPIN(xb_ld(&bar[XB_XGEN(b.x)]) == gen, bar);
            __builtin_amdgcn_fence(__ATOMIC_ACQUIRE, "agent");
            asm volatile("s_waitcnt vmcnt(0)" ::: "memory");
        }
    }
    __syncthreads();
}

__global__ void __launch_bounds__(NTHR, 2) fwd_megakernel(Params p) {
    extern __shared__ __attribute__((aligned(16))) unsigned char lds_raw[];
    LAS unsigned char* lds = (LAS unsigned char*)lds_raw;
    cg::grid_group grid = cg::this_grid();
#define GRID_SYNC() do { asm volatile("s_waitcnt vmcnt(0) lgkmcnt(0)" ::: "memory"); grid.sync(); __builtin_amdgcn_fence(__ATOMIC_ACQUIRE, "agent"); asm volatile("s_waitcnt vmcnt(0)" ::: "memory"); } while (0)
    unsigned char* ws = p.ws;
    volatile LAS unsigned* bst = (volatile LAS unsigned*)(lds + LDS_BYTES - 16);
    if (threadIdx.x == 0) { bst[0] = 0u; bst[1] = 0u; }
    __syncthreads();
    const XcdBarrier xbar = xcd_barrier_post((unsigned*)(ws + WS_BAR), bst);
#define XSYNC() xcd_barrier(xbar)
    const float* MOD = (const float*)(ws + WS_MOD);
    bf16* H = (bf16*)(ws + WS_H); bf16* ACT = (bf16*)(ws + WS_PROJ); bf16* PROJ = (bf16*)(ws + WS_PROJ);
    float* X = p.out;

    phase_ada(p, lds);
    phase_convert(p, 0, lds);
    GRID_SYNC();
    for (int l = 0; l < 2; ++l) {
        const float* modl = MOD + (size_t)l * 8 * NMODC;
        const float* Xin = (l == 0) ? p.in[0] : X;
        if (l == 1) phase_convert(p, 1, lds);
        phase_norm<false>(Xin, p.in[2] + l * D, modl + 0 * D, modl + 1 * D, H, nullptr, nullptr, lds);
        XSYNC();
        { pg8::Gemm g{H, (const bf16*)(ws + WS_W1IN), M, 2 * DFF, D}; pg8::StaticOrder S; S.init(M, 2 * DFF, gridDim.x, blockIdx.x);
          pg8::EpiSwiglu E{ACT, DFF}; pg8::gemm_phase<pg8::EpiSwiglu, pg8::StaticOrder, true, true>(lds, g, S, E); }
        XSYNC();
#if PROBE == 7
        { pg8::Gemm g{H, (const bf16*)(ws + WS_W1IN), M, 2 * DFF, D}; pg8::StaticOrder S; S.init(M, 2 * DFF, gridDim.x, blockIdx.x);
          pg8::EpiSwiglu E{ACT, DFF}; pg8::gemm_phase<pg8::EpiSwiglu, pg8::StaticOrder, true, true>(lds, g, S, E); }
        XSYNC();
#endif
        { pg8::Gemm g{ACT, (const bf16*)(ws + WS_W1OUT), M, D, DFF}; pg8::StaticOrder S; S.init(M, D, gridDim.x, blockIdx.x);
          pg8::EpiResid E{Xin, X, modl + 2 * D, NMODC, 0.5f}; pg8::gemm_phase<pg8::EpiResid, pg8::StaticOrder, true, true>(lds, g, S, E); }
        XSYNC();
        phase_norm<true>(X, p.in[5] + l * D, modl + 3 * D, modl + 4 * D, H, p.in[6] + (size_t)l * 1024 * DIN, (float*)(ws + WS_BA), lds);
        XSYNC();
        { pg8::Gemm g{H, (const bf16*)(ws + WS_WMI), M, NPROJ, D}; pg8::StaticOrder S; S.init(M, NPROJ, gridDim.x, blockIdx.x);
          pg8::EpiBf16Plain E{PROJ, NPROJ}; pg8::gemm_phase<pg8::EpiBf16Plain, pg8::StaticOrder, true, true>(lds, g, S, E); }
        XSYNC();
#if PROBE == 8
        { pg8::Gemm g{H, (const bf16*)(ws + WS_WMI), M, NPROJ, D}; pg8::StaticOrder S; S.init(M, NPROJ, gridDim.x, blockIdx.x);
          pg8::EpiBf16Plain E{PROJ, NPROJ}; pg8::gemm_phase<pg8::EpiBf16Plain, pg8::StaticOrder, true, true>(lds, g, S, E); }
        XSYNC();
#endif
        phase_prep(p, l, lds);
        XSYNC();
#if PROBE == 2
        phase_prep(p, l, lds);
        XSYNC();
#endif
#if PROBE == 3
        XSYNC(); XSYNC(); XSYNC(); XSYNC(); XSYNC(); XSYNC(); XSYNC(); XSYNC();
#endif
        phase_scan(p, l, lds);
        XSYNC();
#if PROBE == 1
        phase_scan(p, l, lds);
        XSYNC();
#endif
        phase_post(p, l);
        XSYNC();
        { pg8::Gemm g{H, (const bf16*)(ws + WS_WMO), M, D, D}; pg8::StaticOrder S; S.init(M, D, gridDim.x, blockIdx.x);
          pg8::EpiResid E{X, X, modl + 5 * D, NMODC, 1.0f}; pg8::gemm_phase<pg8::EpiResid, pg8::StaticOrder, true, true>(lds, g, S, E); }
        XSYNC();
        phase_norm<false>(X, p.in[15] + l * D, modl + 6 * D, modl + 7 * D, H, nullptr, nullptr, lds);
        XSYNC();
        { pg8::Gemm g{H, (const bf16*)(ws + WS_W2IN), M, 2 * DFF, D}; pg8::StaticOrder S; S.init(M, 2 * DFF, gridDim.x, blockIdx.x);
          pg8::EpiSwiglu E{ACT, DFF}; pg8::gemm_phase<pg8::EpiSwiglu, pg8::StaticOrder, true, true>(lds, g, S, E); }
        XSYNC();
        { pg8::Gemm g{ACT, (const bf16*)(ws + WS_W2OUT), M, D, DFF}; pg8::StaticOrder S; S.init(M, D, gridDim.x, blockIdx.x);
          pg8::EpiResid E{X, X, modl + 8 * D, NMODC, 0.5f}; pg8::gemm_phase<pg8::EpiResid, pg8::StaticOrder, true, true>(lds, g, S, E); }
        XSYNC();
    }
    phase_final(X, p.in[20]);
}

extern "C" void kernel_launch(void* const* d_in, const int* in_sizes, int n_in, void* d_out, int out_size, void* d_ws, size_t ws_size, hipStream_t stream) {
    static int grid = 0;
    if (grid == 0) {
        if (n_in != 21 || out_size != M * D || ws_size < WS_END) { fprintf(stderr, "kernel_launch: unexpected shapes: n_in %d out %d ws %zu (need %zu)\n", n_in, out_size, ws_size, (size_t)WS_END); grid = -1; return; }
        int dev = 0, cus = 0, per_cu = 0;
        hipGetDevice(&dev);
        hipDeviceGetAttribute(&cus, hipDeviceAttributeMultiprocessorCount, dev);
        hipFuncSetAttribute((const void*)fwd_megakernel, hipFuncAttributeMaxDynamicSharedMemorySize, LDS_BYTES);
        hipOccupancyMaxActiveBlocksPerMultiprocessor(&per_cu, (const void*)fwd_megakernel, NTHR, LDS_BYTES);
        if (per_cu < 1) { fprintf(stderr, "kernel_launch: occupancy query says %d blocks per CU\n", per_cu); per_cu = 1; }
        grid = cus * 1;
        (void)hipGetLastError();
    }
    if (grid < 0) return;
    hipMemsetAsync((char*)d_ws + WS_MOD, 0, ZERO_BYTES, stream);
    Params p{};
    for (int i = 0; i < 21; ++i) p.in[i] = (const float*)d_in[i];
    p.out = (float*)d_out; p.ws = (unsigned char*)d_ws;
    void* args[] = {&p};
    hipError_t e = hipLaunchCooperativeKernel((const void*)fwd_megakernel, dim3(grid), dim3(NTHR), args, LDS_BYTES, stream);
    if (e != hipSuccess) fprintf(stderr, "cooperative launch failed: %s (grid %d)\n", hipGetErrorString(e), grid);
}
```

```cpp
#include <hip/hip_runtime.h>
#include <hip/hip_cooperative_groups.h>
#include <cstdio>
#include <cstdint>
namespace cg = cooperative_groups;
#ifndef PROBE
#define PROBE 0
#endif
__device__ __forceinline__ int tid_l() { int t = threadIdx.x; asm volatile("" : "+v"(t)); return t; }
namespace pg8 {
#define PG8_LAS __attribute__((address_space(3)))
typedef unsigned short bf16_t;
typedef short bf16x8 __attribute__((ext_vector_type(8)));
typedef float f32x4 __attribute__((ext_vector_type(4)));
typedef unsigned u32x4 __attribute__((ext_vector_type(4)));
constexpr int BM = 256, BK = 64, HALF = 128, HTB = HALF * BK * 2  , STAGE_BYTES = 8 * HTB, NXCD = 8, WGM = 8;

__host__ __device__ __forceinline__ int lds_byte(int r, int c) { const int st = (r >> 4) * 2 + (c >> 5), rr = r & 15, cc = c & 31, ob = rr * 64 + cc * 2; return st * 1024 + (ob ^ (((ob >> 9) & 1) << 5)); }
__host__ __device__ __forceinline__ void stage_rc(int b, int& R, int& C) { const int st = b / 1024, sb = b % 1024, swz = sb ^ (((sb >> 9) & 1) << 5); R = (st >> 1) * 16 + swz / 64; C = (st & 1) * 32 + (swz % 64) / 2; }
__host__ __device__ __forceinline__ int perm32(int rho) { const int n = rho >> 4, i = rho & 15; return 8 * (i >> 2) + 4 * n + (i & 3); }

struct Unit { int pm, pn; };
struct Gemm { const bf16_t* A; const bf16_t* Bt; int M, N, K; };

struct StaticOrder {
    int nM, nN, nwg, G, c;
    __host__ __device__ void init(int M, int N, int G_, int c_) { nM = M / BM; nN = N / BM; nwg = nM * nN; G = G_; c = c_; }
    __host__ __device__ bool next(int i, Unit& u) const {
        const long L = (long)i * G + c; if (L >= nwg) return false;
        int wgid = (int)L; { const int q = nwg / NXCD, r = nwg % NXCD, xcd = wgid % NXCD, off = wgid / NXCD; wgid = (xcd < r ? xcd * (q + 1) : r * (q + 1) + (xcd - r) * q) + off; }
        const int nig = WGM * nN, gid = wgid / nig, fm = gid * WGM, gsz = (nM - fm) < WGM ? (nM - fm) : WGM;
        u.pm = fm + ((wgid % nig) % gsz); u.pn = (wgid % nig) / gsz; return true;
    }
    __device__ __forceinline__ void a_ready(const Unit&) const {}
    __device__ __forceinline__ void done(const Unit&) const {}
};

typedef __bf16 bf16x2n_t __attribute__((ext_vector_type(2)));
typedef float f32x2n_t __attribute__((ext_vector_type(2)));
__device__ __forceinline__ unsigned cvt_pk_bf16(float lo, float hi) { const f32x2n_t v = {lo, hi}; return __builtin_bit_cast(unsigned, __builtin_convertvector(v, bf16x2n_t)); }
typedef float f32x2 __attribute__((ext_vector_type(2)));
__device__ __forceinline__ float silu_f(float g) { return g * __builtin_amdgcn_rcpf(1.0f + __expf(-g)); }
struct EpiBf16Plain {
    static constexpr bool PERM = true, AFTER_DRAIN = false;
    bf16_t* O; int ldc;
    __device__ __forceinline__ void operator()(const f32x4 (&acc)[2][2][4][2], const Unit& u, int wr, int wc, int fr, int fq) const {
        const int row0 = u.pm * BM + wr * 64 + fr, col0 = u.pn * BM + wc * 32 + 8 * fq;
#pragma unroll
        for (int ai = 0; ai < 2; ++ai)
#pragma unroll
            for (int m = 0; m < 4; ++m) { bf16_t* rowp = O + (size_t)(row0 + ai * HALF + m * 16) * ldc + col0;
#pragma unroll
                for (int bj = 0; bj < 2; ++bj) { const f32x4 v0 = acc[ai][bj][m][0], v1 = acc[ai][bj][m][1];
                    u32x4 w; w.x = cvt_pk_bf16(v0[0], v0[1]); w.y = cvt_pk_bf16(v0[2], v0[3]); w.z = cvt_pk_bf16(v1[0], v1[1]); w.w = cvt_pk_bf16(v1[2], v1[3]);
                    *(u32x4*)(rowp + bj * HALF) = w; } }
    }
};
struct EpiSwiglu {
    static constexpr bool PERM = true, AFTER_DRAIN = false;
    bf16_t* O; int ldc;
    __device__ __forceinline__ void operator()(const f32x4 (&acc)[2][2][4][2], const Unit& u, int wr, int wc, int fr, int fq) const {
        const int row0 = u.pm * BM + wr * 64 + fr, col0 = u.pn * HALF + wc * 32 + 8 * fq;
#pragma unroll
        for (int ai = 0; ai < 2; ++ai)
#pragma unroll
            for (int m = 0; m < 4; ++m) { bf16_t* rowp = O + (size_t)(row0 + ai * HALF + m * 16) * ldc + col0;
                const f32x4 g0 = acc[ai][0][m][0], g1 = acc[ai][0][m][1], u0 = acc[ai][1][m][0], u1 = acc[ai][1][m][1];
                u32x4 w;
                w.x = cvt_pk_bf16(silu_f(g0[0]) * u0[0], silu_f(g0[1]) * u0[1]); w.y = cvt_pk_bf16(silu_f(g0[2]) * u0[2], silu_f(g0[3]) * u0[3]);
                w.z = cvt_pk_bf16(silu_f(g1[0]) * u1[0], silu_f(g1[1]) * u1[1]); w.w = cvt_pk_bf16(silu_f(g1[2]) * u1[2], silu_f(g1[3]) * u1[3]);
                *(u32x4*)rowp = w; }
    }
};
struct EpiResid {
    static constexpr bool PERM = false, AFTER_DRAIN = false;
    const float* base; float* out; const float* gate; int gpitch; float mul;
    __device__ __forceinline__ void operator()(const f32x4 (&acc)[2][2][4][2], const Unit& u, int wr, int wc, int fr, int fq) const {
        const int b = (u.pm * BM) >> 11;
        const int col0 = u.pn * BM + wc * 32 + 4 * fq;
        f32x4 gv[2][2];
#pragma unroll
        for (int bj = 0; bj < 2; ++bj)
#pragma unroll
            for (int n = 0; n < 2; ++n) gv[bj][n] = *(const f32x4*)(gate + (size_t)b * gpitch + col0 + bj * HALF + n * 16) * mul;
#pragma unroll
        for (int ai = 0; ai < 2; ++ai)
#pragma unroll
            for (int m = 0; m < 4; ++m) { const size_t off = (size_t)(u.pm * BM + ai * HALF + wr * 64 + m * 16 + fr) * 1024 + col0;
#pragma unroll
                for (int bj = 0; bj < 2; ++bj)
#pragma unroll
                    for (int n = 0; n < 2; ++n) { const f32x4 bs = *(const f32x4*)(base + off + bj * HALF + n * 16);
                        *(f32x4*)(out + off + bj * HALF + n * 16) = bs + gv[bj][n] * acc[ai][bj][m][n]; } }
    }
};
template <class Epi, class Sched, bool ALIGN_EPI = false, bool SP2 = false>
__device__ __forceinline__ void gemm_phase(PG8_LAS unsigned char* lds, const Gemm g, const Sched& S, const Epi& E) {
    const int tid = tid_l(), wid = __builtin_amdgcn_readfirstlane(tid >> 6), lane = tid & 63, wr = wid >> 2, wc = wid & 3, fr = lane & 15, fq = lane >> 4;
    const int K = g.K, nt = K / BK;
    unsigned voffA[2], voffB[2];
#pragma unroll
    for (int i = 0; i < 2; ++i) { int R, C; stage_rc(tid * 16 + i * 8192, R, C); const int Rb = Epi::PERM ? ((R & ~31) + perm32(R & 31)) : R;
        voffA[i] = (unsigned)(R * K + C) * 2u; voffB[i] = (unsigned)(Rb * K + C) * 2u; }
    const size_t kstep = (size_t)(BK * 2);
    const size_t hstep = (size_t)HALF * K * 2;
    const size_t tstep = 2 * hstep;
    const unsigned ldsw = (unsigned)wid * 1024u;
    const int aoff = lds_byte(wr * 64 + fr, fq * 8), boff = lds_byte(wc * 32 + fr, fq * 8);
#define PG8_SA(b, h) (((b) * 2 + (h)) * HTB)
#define PG8_SB(b, h) ((4 + (b) * 2 + (h)) * HTB)
#define PG8_STAGE(bufoff, gbase, voff) do { _Pragma("unroll") for (int _i = 0; _i < 2; ++_i) \
        __builtin_amdgcn_global_load_lds((const unsigned*)((const char*)(gbase) + (voff)[_i]), (PG8_LAS unsigned*)(lds + (bufoff) + ldsw + _i * 8192), 16, 0, 0); } while (0)
#define PG8_LDA(dst, b, h) do { _Pragma("unroll") for (int m = 0; m < 4; ++m) _Pragma("unroll") for (int k = 0; k < 2; ++k) dst[m][k] = *(const PG8_LAS bf16x8*)(lds + PG8_SA(b, h) + aoff + m * 2048 + k * 1024); } while (0)
#define PG8_LDB(dst, b, h) do { _Pragma("unroll") for (int n = 0; n < 2; ++n) _Pragma("unroll") for (int k = 0; k < 2; ++k) dst[n][k] = *(const PG8_LAS bf16x8*)(lds + PG8_SB(b, h) + boff + n * 2048 + k * 1024); } while (0)
#define PG8_MMA(ai, bj, At, Bt) do { __builtin_amdgcn_s_setprio(1); _Pragma("unroll") for (int m = 0; m < 4; ++m) _Pragma("unroll") for (int n = 0; n < 2; ++n) _Pragma("unroll") for (int k = 0; k < 2; ++k) \
        acc[ai][bj][m][n] = __builtin_amdgcn_mfma_f32_16x16x32_bf16(Bt[n][k], At[m][k], acc[ai][bj][m][n], 0, 0, 0); __builtin_amdgcn_s_setprio(0); } while (0)
#define PG8_WAIT_V(n) asm volatile("s_waitcnt vmcnt(" #n ")" ::: "memory")
#define PG8_WAIT_L(n) asm volatile("s_waitcnt lgkmcnt(" #n ")" ::: "memory")
#define PG8_BAR __builtin_amdgcn_s_barrier()
#define PG8_SCHED __builtin_amdgcn_sched_barrier(0)
    Unit cur, nxt; int ui = 0;
    if (!S.next(0, cur)) return;
    f32x4 acc[2][2][4][2];
#pragma unroll
    for (int a = 0; a < 2; ++a)
#pragma unroll
        for (int b = 0; b < 2; ++b)
#pragma unroll
            for (int m = 0; m < 4; ++m)
#pragma unroll
                for (int n = 0; n < 2; ++n) acc[a][b][m][n] = (f32x4){0.f, 0.f, 0.f, 0.f};
    bf16x8 At[4][2], B0[2][2], B1[2][2];
    const char* cA = (const char*)g.A + (size_t)cur.pm * tstep; const char* cB = (const char*)g.Bt + (size_t)cur.pn * tstep;
    S.a_ready(cur);
    if constexpr (SP2) {
        PG8_STAGE(PG8_SB(0, 0), cB, voffB); PG8_STAGE(PG8_SB(0, 1), cB + hstep, voffB); PG8_STAGE(PG8_SA(0, 0), cA, voffA); PG8_STAGE(PG8_SA(0, 1), cA + hstep, voffA);
        if (wr == 1) PG8_BAR;
        PG8_WAIT_V(2); PG8_BAR;
        PG8_STAGE(PG8_SB(1, 0), cB + kstep, voffB); PG8_STAGE(PG8_SA(1, 0), cA + kstep, voffA); PG8_STAGE(PG8_SB(1, 1), cB + hstep + kstep, voffB);
        PG8_WAIT_V(6); PG8_BAR;
    } else {
        PG8_STAGE(PG8_SB(0, 0), cB, voffB); PG8_STAGE(PG8_SA(0, 0), cA, voffA); PG8_STAGE(PG8_SB(0, 1), cB + hstep, voffB); PG8_STAGE(PG8_SA(0, 1), cA + hstep, voffA);
        if (wr == 1) PG8_BAR;
        PG8_WAIT_V(4); PG8_BAR;
        PG8_STAGE(PG8_SB(1, 0), cB + kstep, voffB); PG8_STAGE(PG8_SA(1, 0), cA + kstep, voffA); PG8_STAGE(PG8_SB(1, 1), cB + hstep + kstep, voffB);
        PG8_WAIT_V(6); PG8_BAR;
    }
    for (;;) {
        const bool has_next = S.next(ui + 1, nxt);
        const char* nA = has_next ? (const char*)g.A + (size_t)nxt.pm * tstep : cA; const char* nB = has_next ? (const char*)g.Bt + (size_t)nxt.pn * tstep : cB;
        for (int t = 0; t < nt; t += 2) {
            const bool last = (t == nt - 2);
            const char* a1 = cA + (size_t)(t + 1) * kstep;
            const char* a2 = last ? nA : cA + (size_t)(t + 2) * kstep; const char* b2 = last ? nB : cB + (size_t)(t + 2) * kstep;
            const char* a3 = a2 + kstep; const char* b3 = b2 + kstep;
            if (last && has_next) S.a_ready(nxt);
            if constexpr (SP2) {
            PG8_LDB(B0, 0, 0); PG8_LDB(B1, 0, 1); PG8_SCHED; PG8_LDA(At, 0, 0); PG8_STAGE(PG8_SA(1, 1), a1 + hstep, voffA);
            PG8_WAIT_V(8); PG8_WAIT_L(0); PG8_BAR; PG8_MMA(0, 0, At, B0); PG8_MMA(0, 1, At, B1); PG8_BAR; PG8_SCHED;
            PG8_LDA(At, 0, 1); PG8_STAGE(PG8_SB(0, 0), b2, voffB); PG8_STAGE(PG8_SB(0, 1), b2 + hstep, voffB); PG8_STAGE(PG8_SA(0, 0), a2, voffA);
            PG8_WAIT_V(8); PG8_WAIT_L(0); PG8_BAR; PG8_MMA(1, 0, At, B0); PG8_MMA(1, 1, At, B1); PG8_BAR; PG8_SCHED;
            PG8_LDB(B0, 1, 0); PG8_LDB(B1, 1, 1); PG8_SCHED; PG8_LDA(At, 1, 0); PG8_STAGE(PG8_SA(0, 1), a2 + hstep, voffA);
            PG8_WAIT_V(8); PG8_WAIT_L(0); PG8_BAR; PG8_MMA(0, 0, At, B0); PG8_MMA(0, 1, At, B1); PG8_BAR; PG8_SCHED;
            PG8_LDA(At, 1, 1); PG8_STAGE(PG8_SB(1, 0), b3, voffB); PG8_STAGE(PG8_SB(1, 1), b3 + hstep, voffB); PG8_STAGE(PG8_SA(1, 0), a3, voffA);
            PG8_WAIT_V(8); PG8_WAIT_L(0); PG8_BAR; PG8_MMA(1, 0, At, B0); PG8_MMA(1, 1, At, B1); PG8_BAR; PG8_SCHED;
            } else {
            PG8_LDB(B0, 0, 0); PG8_SCHED; PG8_LDA(At, 0, 0); PG8_STAGE(PG8_SA(1, 1), a1 + hstep, voffA);
            PG8_WAIT_L(8); PG8_BAR; PG8_WAIT_L(0); PG8_MMA(0, 0, At, B0); PG8_BAR; PG8_SCHED;
            PG8_LDB(B1, 0, 1); PG8_STAGE(PG8_SB(0, 0), b2, voffB);
            PG8_BAR; PG8_WAIT_L(0); PG8_MMA(0, 1, At, B1); PG8_BAR;
            PG8_LDA(At, 0, 1); PG8_STAGE(PG8_SA(0, 0), a2, voffA);
            PG8_BAR; PG8_WAIT_L(0); PG8_MMA(1, 0, At, B0); PG8_BAR; PG8_SCHED;
            PG8_STAGE(PG8_SB(0, 1), b2 + hstep, voffB);
            PG8_WAIT_V(6); PG8_BAR; PG8_MMA(1, 1, At, B1); PG8_BAR;
            PG8_LDB(B0, 1, 0); PG8_SCHED; PG8_LDA(At, 1, 0); PG8_STAGE(PG8_SA(0, 1), a2 + hstep, voffA);
            PG8_WAIT_L(8); PG8_BAR; PG8_WAIT_L(0); PG8_MMA(0, 0, At, B0); PG8_BAR; PG8_SCHED;
            PG8_LDB(B1, 1, 1); PG8_STAGE(PG8_SB(1, 0), b3, voffB);
            PG8_BAR; PG8_WAIT_L(0); PG8_MMA(0, 1, At, B1); PG8_BAR;
            PG8_LDA(At, 1, 1); PG8_STAGE(PG8_SA(1, 0), a3, voffA);
            PG8_BAR; PG8_WAIT_L(0); PG8_MMA(1, 0, At, B0); PG8_BAR; PG8_SCHED;
            PG8_STAGE(PG8_SB(1, 1), b3 + hstep, voffB);
            PG8_WAIT_V(6); PG8_BAR; PG8_MMA(1, 1, At, B1); PG8_BAR;
            }
        }
        if constexpr (ALIGN_EPI) { if (wr == 0) PG8_BAR; }
        if constexpr (!Epi::AFTER_DRAIN) { E(acc, cur, wr, wc, fr, fq); S.done(cur); }
        if (!has_next) break;
#pragma unroll
        for (int a = 0; a < 2; ++a)
#pragma unroll
            for (int b = 0; b < 2; ++b)
#pragma unroll
                for (int m = 0; m < 4; ++m)
#pragma unroll
                    for (int n = 0; n < 2; ++n) acc[a][b][m][n] = (f32x4){0.f, 0.f, 0.f, 0.f};
        cur = nxt; cA = nA; cB = nB; ++ui;
        if constexpr (ALIGN_EPI) { if (wr == 1) PG8_BAR; }
    }
    PG8_WAIT_V(0);
    if constexpr (!ALIGN_EPI) { if (wr == 0) PG8_BAR; }
    PG8_BAR;
    if constexpr (Epi::AFTER_DRAIN) { E.fused(acc, cur, wr, wc, fr, fq, lds, wid, lane); S.done(cur); }
#undef PG8_SA
#undef PG8_SB
#undef PG8_STAGE
#undef PG8_LDA
#undef PG8_LDB
#undef PG8_MMA
#undef PG8_WAIT_V
#undef PG8_WAIT_L
#undef PG8_BAR
#undef PG8_SCHED
}
}
#define LAS __attribute__((address_space(3)))
typedef unsigned short bf16;
typedef float f32x4 __attribute__((ext_vector_type(4)));
typedef float f32x2 __attribute__((ext_vector_type(2)));
typedef unsigned u32x4 __attribute__((ext_vector_type(4)));
typedef unsigned u32x2 __attribute__((ext_vector_type(2)));

constexpr int D = 1024, BATCH = 8, SEQ = 2048, M = BATCH * SEQ, DFF = 2816, NMODC = 9 * 1024, DIN = 3848, NPROJ = 3840;
constexpr int NWAVES = 8, NTHR = 512;
constexpr float EPS = 1e-6f;
constexpr int PC_SBQ = 0, PC_SBK = 256, PC_SBV = 512, PC_GQ = 768, PC_GZ = 2304, PC_HQ = 2816, PC_HF = 3072, PC_HI = 3328, PC_HG = 3584;
constexpr size_t MiB = 1u << 20;
constexpr size_t WS_MOD = 0, MOD_BYTES = (size_t)2 * 8 * NMODC * 4, WS_BAR = 768 * 1024, WS_TASK = 800 * 1024, ZERO_BYTES = 1 * MiB;
constexpr size_t WS_BA = 1 * MiB, WS_GS = 2 * MiB, WS_W1IN = 3 * MiB, WS_W1OUT = 14 * MiB, WS_WMI = 20 * MiB, WS_WMO = 28 * MiB, WS_W2IN = 30 * MiB, WS_W2OUT = 41 * MiB;
constexpr size_t WS_H = 47 * MiB, WS_PROJ = 79 * MiB, WS_QD = 199 * MiB, WS_W = 215 * MiB, WS_U = 231 * MiB, WS_OMIX = 247 * MiB, WS_KDT = 263 * MiB, WS_AQK = 279 * MiB, WS_VT = 287 * MiB, WS_CD = 295 * MiB, WS_P3 = 296 * MiB, WS_END = 304 * MiB;
constexpr int LDS_BYTES = 147456;

struct Params { const float* in[21]; float* out; unsigned char* ws; };

__device__ __forceinline__ float bflo(unsigned u) { return __uint_as_float(u << 16); }
__device__ __forceinline__ float bfhi(unsigned u) { return __uint_as_float(u & 0xffff0000u); }
typedef __bf16 bf16x2v_t __attribute__((ext_vector_type(2)));
__device__ __forceinline__ unsigned pk2(float lo, float hi) { const f32x2 v = {lo, hi}; return __builtin_bit_cast(unsigned, __builtin_convertvector(v, bf16x2v_t)); }
__device__ __forceinline__ unsigned f2bf(float f) { return pk2(f, 0.f) & 0xffffu; }
__device__ __forceinline__ float wave_sum(float v) {
#pragma unroll
    for (int o = 1; o < 64; o <<= 1) v += __shfl_xor(v, o);
    return v;
}
template <int CTRL> __device__ __forceinline__ float dpp_mov(float x) { return __int_as_float(__builtin_amdgcn_update_dpp(0, __float_as_int(x), CTRL, 0xF, 0xF, false)); }
__device__ __forceinline__ float rlane(float x, int l) { return __uint_as_float(__builtin_amdgcn_readlane(__float_as_uint(x), l)); }
__device__ __forceinline__ float wave_sum_fast(float x) {
    x += dpp_mov<0xB1>(x); x += dpp_mov<0x4E>(x); x += dpp_mov<0x141>(x); x += dpp_mov<0x140>(x);
    return (rlane(x, 0) + rlane(x, 16)) + (rlane(x, 32) + rlane(x, 48));
}
__device__ __forceinline__ float silu(float g) { return g * __builtin_amdgcn_rcpf(1.0f + __expf(-g)); }
__device__ __forceinline__ float softplus_precise(float x) { return fmaxf(x, 0.f) + log1pf(expf(-fabsf(x))); }

__device__ __forceinline__ void phase_ada(const Params& p, LAS unsigned char* lds) {
    LAS float* sc = (LAS float*)lds;
    const float* c = p.in[1];
    for (int i = tid_l(); i < 8 * 1024; i += NTHR) { const float v = c[i]; sc[i] = v / (1.0f + expf(-v)); }
    __syncthreads();
    float* MOD = (float*)(p.ws + WS_MOD);
    for (int item = blockIdx.x; item < 288; item += gridDim.x) {
        const int l = item / 144, r = item % 144, cgp = r >> 3, ks = r & 7;
        const int n = cgp * 512 + tid_l();
        const float* W = p.in[18] + (size_t)l * 1024 * NMODC + n;
        float acc[8];
#pragma unroll
        for (int b = 0; b < 8; ++b) acc[b] = 0.f;
        for (int k = ks * 128; k < ks * 128 + 128; ++k) { const float w = W[(size_t)k * NMODC];
#pragma unroll
            for (int b = 0; b < 8; ++b) acc[b] += sc[b * 1024 + k] * w; }
        const float bias = (ks == 0) ? p.in[19][l * NMODC + n] : 0.f;
#pragma unroll
        for (int b = 0; b < 8; ++b) atomicAdd(&MOD[(size_t)(l * 8 + b) * NMODC + n], acc[b] + bias);
    }
    __syncthreads();
}

__device__ __forceinline__ void transpose_item(const float* W, int Nsrc, int K, int k0, int nsrc0, bf16* WT, int drow0, LAS float* scr, int lane) {
#pragma unroll 8
    for (int i = 0; i < 32; ++i) { const int kk = 2 * i + (lane >> 5); scr[kk * 33 + (lane & 31)] = W[(size_t)(k0 + kk) * Nsrc + nsrc0 + (lane & 31)]; }
    asm volatile("s_waitcnt lgkmcnt(0)" ::: "memory");
    const int c = lane & 7;
#pragma unroll
    for (int j = 0; j < 4; ++j) { const int n = (lane >> 3) + 8 * j; const LAS float* s = scr + (8 * c) * 33 + n;
        u32x4 o; o.x = pk2(s[0 * 33], s[1 * 33]); o.y = pk2(s[2 * 33], s[3 * 33]); o.z = pk2(s[4 * 33], s[5 * 33]); o.w = pk2(s[6 * 33], s[7 * 33]);
        *(u32x4*)(WT + (size_t)(drow0 + n) * K + k0 + 8 * c) = o; }
    asm volatile("s_waitcnt lgkmcnt(0)" ::: "memory");
}
__device__ __forceinline__ void phase_convert(const Params& p, int l, LAS unsigned char* lds) {
    const int tid_ = tid_l(); const int wave = __builtin_amdgcn_readfirstlane(tid_ >> 6), lane = tid_ & 63;
    LAS float* scr = (LAS float*)(lds + wave * 16384);
    const int gw = blockIdx.x * NWAVES + wave, NGW = gridDim.x * NWAVES;
    unsigned char* ws = p.ws;
    constexpr int I_IN = 16 * 176, I_OUT = 44 * 32, I_MI = 16 * 120, I_MO = 16 * 32;
    constexpr int NITEMS = 2 * (I_IN + I_OUT) + I_MI + I_MO;
    for (int it = gw; it < NITEMS; it += NGW) {
        int r = it;
        if (r < I_IN || (r >= I_IN + I_OUT + I_MI + I_MO && r < 2 * I_IN + I_OUT + I_MI + I_MO)) {
            const bool second = r >= I_IN; if (second) r -= I_IN + I_OUT + I_MI + I_MO;
            const float* W = (second ? p.in[16] : p.in[3]) + (size_t)l * 1024 * 2 * DFF;
            bf16* WT = (bf16*)(ws + (second ? WS_W2IN : WS_W1IN));
            const int kb = r / 176, nb = r % 176, dn0 = nb * 32, pn = dn0 >> 8, bj = (dn0 >> 7) & 1, j = dn0 & 127;
            transpose_item(W, 2 * DFF, 1024, kb * 64, bj * DFF + pn * 128 + j, WT, dn0, scr, lane);
            continue;
        }
        r -= I_IN;
        if (r < I_OUT) { const float* W = p.in[4] + (size_t)l * DFF * 1024; transpose_item(W, 1024, DFF, (r / 32) * 64, (r % 32) * 32, (bf16*)(ws + WS_W1OUT), (r % 32) * 32, scr, lane); continue; }
        r -= I_OUT;
        if (r < I_MI) { const float* W = p.in[6] + (size_t)l * 1024 * DIN; const int dn0 = (r % 120) * 32; transpose_item(W, DIN, 1024, (r / 120) * 64, dn0 < 2816 ? dn0 : dn0 + 8, (bf16*)(ws + WS_WMI), dn0, scr, lane); continue; }
        r -= I_MI;
        if (r < I_MO) { const float* W = p.in[14] + (size_t)l * 1024 * 1024; transpose_item(W, 1024, 1024, (r / 32) * 64, (r % 32) * 32, (bf16*)(ws + WS_WMO), (r % 32) * 32, scr, lane); continue; }
        r -= I_MO; r -= I_IN;
        { const float* W = p.in[17] + (size_t)l * DFF * 1024; transpose_item(W, 1024, DFF, (r / 32) * 64, (r % 32) * 32, (bf16*)(ws + WS_W2OUT), (r % 32) * 32, scr, lane); }
    }
}

template <bool WITH_BA>
__device__ __forceinline__ void phase_norm(const float* X, const float* gain, const float* shiftp, const float* scalep, bf16* H,
                                           const float* wmi, float* BAout, LAS unsigned char* lds) {
    const int tid_ = tid_l(); const int wave = __builtin_amdgcn_readfirstlane(tid_ >> 6), lane = tid_ & 63;
    LAS float* wba = (LAS float*)lds;
    if (WITH_BA) {
        for (int i = tid_; i < 1024 * 8; i += NTHR) wba[i] = wmi[(size_t)(i >> 3) * DIN + 2816 + (i & 7)];
        __syncthreads();
    }
    const int gw = blockIdx.x * NWAVES + wave, NGW = gridDim.x * NWAVES;
    for (int rg = gw; rg < M / 8; rg += NGW) {
        const int b = (rg * 8) >> 11;
        f32x4 gp[4], sh[4];
#pragma unroll
        for (int j = 0; j < 4; ++j) { const int col = 256 * j + 4 * lane;
            const f32x4 g = *(const f32x4*)(gain + col), s = *(const f32x4*)(scalep + (size_t)b * NMODC + col);
            gp[j] = g * (1.0f + s); sh[j] = *(const f32x4*)(shiftp + (size_t)b * NMODC + col); }
        for (int i = 0; i < 8; ++i) {
            const int m = rg * 8 + i;
            f32x4 v[4]; float ss = 0.f;
#pragma unroll
            for (int j = 0; j < 4; ++j) { v[j] = *(const f32x4*)(X + (size_t)m * D + 256 * j + 4 * lane); ss += (v[j].x * v[j].x + v[j].y * v[j].y) + (v[j].z * v[j].z + v[j].w * v[j].w); }
            const float rstd = __builtin_amdgcn_rsqf(wave_sum_fast(ss) * (1.0f / D) + EPS);
#pragma unroll
            for (int j = 0; j < 4; ++j) { v[j] = v[j] * rstd * gp[j] + sh[j];
                u32x2 o; o.x = pk2(v[j].x, v[j].y); o.y = pk2(v[j].z, v[j].w);
                *(u32x2*)(H + (size_t)m * D + 256 * j + 4 * lane) = o; }
            if (WITH_BA) {
                float acc[8];
#pragma unroll
                for (int q = 0; q < 8; ++q) acc[q] = 0.f;
#pragma unroll
                for (int j = 0; j < 4; ++j)
#pragma unroll
                    for (int e = 0; e < 4; ++e) { const int k = 256 * j + 4 * lane + e; const f32x4 w0 = *(const LAS f32x4*)(wba + k * 8), w1 = *(const LAS f32x4*)(wba + k * 8 + 4); const float hv = v[j][e];
                        acc[0] += hv * w0.x; acc[1] += hv * w0.y; acc[2] += hv * w0.z; acc[3] += hv * w0.w; acc[4] += hv * w1.x; acc[5] += hv * w1.y; acc[6] += hv * w1.z; acc[7] += hv * w1.w; }
#pragma unroll
                for (int q = 0; q < 8; ++q) acc[q] = wave_sum(acc[q]);
                if (lane == 0) { *(f32x4*)(BAout + (size_t)m * 8) = (f32x4){acc[0], acc[1], acc[2], acc[3]}; *(f32x4*)(BAout + (size_t)m * 8 + 4) = (f32x4){acc[4], acc[5], acc[6], acc[7]}; }
            }
        }
    }
    if (WITH_BA) __syncthreads();
}

__device__ __forceinline__ void phase_final(float* X, const float* gain) {
    const int tid_ = tid_l(); const int wave = __builtin_amdgcn_readfirstlane(tid_ >> 6), lane = tid_ & 63;
    const int gw = blockIdx.x * NWAVES + wave, NGW = gridDim.x * NWAVES;
    f32x4 g[4];
#pragma unroll
    for (int j = 0; j < 4; ++j) g[j] = *(const f32x4*)(gain + 256 * j + 4 * lane);
    for (int m = gw; m < M; m += NGW) {
        f32x4 v[4]; float ss = 0.f;
#pragma unroll
        for (int j = 0; j < 4; ++j) { v[j] = *(const f32x4*)(X + (size_t)m * D + 256 * j + 4 * lane); ss += (v[j].x * v[j].x + v[j].y * v[j].y) + (v[j].z * v[j].z + v[j].w * v[j].w); }
        const float rstd = __builtin_amdgcn_rsqf(wave_sum_fast(ss) * (1.0f / D) + EPS);
#pragma unroll
        for (int j = 0; j < 4; ++j) *(f32x4*)(X + (size_t)m * D + 256 * j + 4 * lane) = v[j] * rstd * g[j];
    }
}

#define LDS_BARRIER() do { asm volatile("s_waitcnt lgkmcnt(0)" ::: "memory"); __builtin_amdgcn_s_barrier(); asm volatile("" ::: "memory"); } while (0)
typedef short bf16x8_t __attribute__((ext_vector_type(8)));
__device__ __forceinline__ void phase_prep(const Params& p, int l, LAS unsigned char* lds) {
    const int tid_ = tid_l(); const int wave = __builtin_amdgcn_readfirstlane(tid_ >> 6), lane = tid_ & 63;
    const int gw = blockIdx.x * NWAVES + wave, NGW = gridDim.x * NWAVES;
    const bf16* PROJ = (const bf16*)(p.ws + WS_PROJ); const float* BA = (const float*)(p.ws + WS_BA);
    {
        LAS bf16* tile = (LAS bf16*)(lds + wave * 16384); bf16* VT = (bf16*)(p.ws + WS_VT);
        for (int item = gw; item < 1024; item += NGW) {
            const int bh = item >> 5, tb = item & 31, b = bh >> 2, h = bh & 3; const size_t mt = (size_t)b * SEQ + tb * 64;
#pragma unroll
            for (int r0 = 0; r0 < 64; r0 += 16) { unsigned tv[16];
#pragma unroll
                for (int r = 0; r < 16; ++r) tv[r] = PROJ[(mt + r0 + r) * NPROJ + PC_SBV + h * 64 + lane];
#pragma unroll
                for (int r = 0; r < 16; ++r) tile[(r0 + r) * 66 + lane] = (bf16)tv[r]; }
            asm volatile("s_waitcnt lgkmcnt(0)" ::: "memory");
#pragma unroll 16
            for (int d = 0; d < 64; ++d) VT[((size_t)bh * 64 + d) * SEQ + tb * 64 + lane] = tile[lane * 66 + d];
            asm volatile("s_waitcnt lgkmcnt(0)" ::: "memory");
        }
        __syncthreads();
    }
    bf16* QD = (bf16*)(p.ws + WS_QD); bf16* Wg = (bf16*)(p.ws + WS_W); bf16* Ug = (bf16*)(p.ws + WS_U);
    bf16* KDT = (bf16*)(p.ws + WS_KDT); bf16* AQK = (bf16*)(p.ws + WS_AQK); float* CD = (float*)(p.ws + WS_CD);
    const float* cw = p.in[7] + (size_t)l * 4 * 1536; const float* A_log = p.in[8] + l * 4; const float* dtb = p.in[9] + l * 4;
    LAS bf16* Kb = (LAS bf16*)lds; LAS bf16* Qb = Kb + 64 * 136; LAS bf16* Vb = Qb + 64 * 136;
    LAS float* Akk = (LAS float*)(lds + 3 * 17408);
    LAS float* s_la = Akk + 64 * 68; LAS float* s_beta = s_la + 64; LAS float* s_g = s_beta + 64; LAS float* s_eg = s_g + 64;
    const int g = lane >> 4, c = lane & 15;
    for (int unit = blockIdx.x; unit < 1024; unit += gridDim.x) {
        const int bh = unit >> 5, n = unit & 31, b = bh >> 2, h = bh & 3; const size_t m0 = (size_t)b * SEQ + n * 64;
        const int cq = h * 128 + 2 * lane;
        f32x2 cwq[4], cwk[4], cwv[4];
#pragma unroll
        for (int j = 0; j < 4; ++j) { cwq[j] = *(const f32x2*)(cw + j * 1536 + cq); cwk[j] = *(const f32x2*)(cw + j * 1536 + 512 + cq); cwv[j] = *(const f32x2*)(cw + j * 1536 + 1024 + cq); }
        unsigned xq[11], xk[11], xv[11];
#pragma unroll
        for (int rr = 0; rr < 11; ++rr) { const int r_ = wave * 8 - 3 + rr;
            if (n * 64 + r_ >= 0) { const bf16* row = PROJ + (size_t)((long)m0 + r_) * NPROJ + PC_GQ + cq; xq[rr] = *(const unsigned*)row; xk[rr] = *(const unsigned*)(row + 512); xv[rr] = *(const unsigned*)(row + 1024); }
            else { xq[rr] = 0u; xk[rr] = 0u; xv[rr] = 0u; } }
#pragma unroll
        for (int i = 0; i < 8; ++i) {
            const int r = wave * 8 + i; const size_t m = m0 + r;
            float q0 = 0.f, q1 = 0.f, k0 = 0.f, k1 = 0.f, v0 = 0.f, v1 = 0.f;
#pragma unroll
            for (int j = 0; j < 4; ++j) { const unsigned uq = xq[i + j], uk = xk[i + j], uv = xv[i + j];
                q0 += cwq[j].x * bflo(uq); q1 += cwq[j].y * bfhi(uq); k0 += cwk[j].x * bflo(uk); k1 += cwk[j].y * bfhi(uk); v0 += cwv[j].x * bflo(uv); v1 += cwv[j].y * bfhi(uv); }
            q0 = silu(q0); q1 = silu(q1); k0 = silu(k0); k1 = silu(k1); v0 = silu(v0); v1 = silu(v1);
            const float sq = wave_sum_fast(q0 * q0 + q1 * q1), sk = wave_sum_fast(k0 * k0 + k1 * k1);
            const float rq = (__builtin_amdgcn_rsqf(sq + EPS)) * 0.08838834764831845f, rk = __builtin_amdgcn_rsqf(sk + EPS);
            *(LAS unsigned*)(Qb + r * 136 + 2 * lane) = pk2(q0 * rq, q1 * rq); *(LAS unsigned*)(Kb + r * 136 + 2 * lane) = pk2(k0 * rk, k1 * rk); *(LAS unsigned*)(Vb + r * 136 + 2 * lane) = pk2(v0, v1);
            if (lane == 0) {
                s_beta[r] = 1.0f / (1.0f + expf(-BA[m * 8 + h]));
                s_la[r] = -expf(A_log[h]) * softplus_precise(BA[m * 8 + 4 + h] + dtb[h]);
            }
        }
        LDS_BARRIER();
        if (wave == 0) { float x = s_la[lane];
#pragma unroll
            for (int o = 1; o < 64; o <<= 1) { const float tmp = __shfl_up(x, o); if (lane >= o) x += tmp; }
            s_g[lane] = x; s_eg[lane] = expf(x); }
        LDS_BARRIER();
        for (int q = 0; q < 4; ++q) {
            const int idx = wave * 4 + q; const bool isQK = idx >= 16; const int ti = (idx >> 2) & 3, tj = idx & 3;
            f32x4 acc = (f32x4){0.f, 0.f, 0.f, 0.f};
            if (tj <= ti) {
                const LAS bf16* X = isQK ? Qb : Kb;
#pragma unroll
                for (int ks = 0; ks < 4; ++ks) { const bf16x8_t a = *(const LAS bf16x8_t*)(X + (16 * ti + c) * 136 + 32 * ks + 8 * g), bb = *(const LAS bf16x8_t*)(Kb + (16 * tj + c) * 136 + 32 * ks + 8 * g);
                    acc = __builtin_amdgcn_mfma_f32_16x16x32_bf16(a, bb, acc, 0, 0, 0); }
            }
#pragma unroll
            for (int i = 0; i < 4; ++i) { const int row = 16 * ti + 4 * g + i, col = 16 * tj + c;
                const float dec = (col <= row) ? __expf(s_g[row] - s_g[col]) : 0.f;
                if (isQK) AQK[((size_t)unit * 64 + row) * 64 + col] = (bf16)f2bf(dec * acc[i]);
                else Akk[col * 68 + row] = (col < row) ? s_beta[row] * dec * acc[i] : 0.f; }
        }
        LDS_BARRIER();
        if (wave < 4) {
            const bool isW = wave >= 2; const int col = tid_ & 127;
            const LAS bf16* src = isW ? Kb : Vb; bf16* dst = (isW ? Wg : Ug) + m0 * 512 + h * 128 + col;
            float X[64];
            int lz; asm volatile("v_mov_b32 %0, 0" : "=v"(lz));
            const LAS float* Ak = Akk + lz; const LAS float* sb_ = s_beta + lz; const LAS float* se_ = s_eg + lz;
#pragma unroll
            for (int i = 0; i < 64; ++i) { X[i] = sb_[i] * (isW ? se_[i] : 1.0f) * __uint_as_float((unsigned)src[i * 136 + col] << 16);
                if ((i & 7) == 7) asm volatile("" : "+v"(X[i - 7]), "+v"(X[i - 6]), "+v"(X[i - 5]), "+v"(X[i - 4]), "+v"(X[i - 3]), "+v"(X[i - 2]), "+v"(X[i - 1]), "+v"(X[i]) :: "memory"); }
#pragma unroll
            for (int j = 0; j < 63; ++j) {
                f32x4 arow[16];
#pragma unroll
                for (int i4 = (j >> 2) << 2; i4 < 64; i4 += 4) arow[i4 >> 2] = *(const LAS f32x4*)(Ak + j * 68 + i4);
                const float xj = X[j];
                *dst = (bf16)f2bf(xj); dst += 512; asm volatile("" : "+v"(dst));
                asm volatile("s_waitcnt lgkmcnt(0)" ::: "memory");
#pragma unroll
                for (int i4 = (j >> 2) << 2; i4 < 64; i4 += 4) { const f32x4 a = arow[i4 >> 2];
                    X[i4] -= a.x * xj; X[i4 + 1] -= a.y * xj; X[i4 + 2] -= a.z * xj; X[i4 + 3] -= a.w * xj; }
            }
            *dst = (bf16)f2bf(X[63]);
        } else {
            const int t2 = tid_ - 256;
            for (int idx = t2; idx < 64 * 64; idx += 256) { const int r = idx >> 6, dp = idx & 63; const unsigned u = *(const LAS unsigned*)(Qb + r * 136 + 2 * dp); const float e = s_eg[r];
                *(unsigned*)(QD + (m0 + r) * 512 + h * 128 + 2 * dp) = pk2(bflo(u) * e, bfhi(u) * e); }
            const int cc = t2 & 63; const float kd = __expf(s_g[63] - s_g[cc]);
            for (int d = t2 >> 6; d < 128; d += 4) KDT[((size_t)unit * 128 + d) * 64 + cc] = (bf16)f2bf(__uint_as_float((unsigned)Kb[cc * 136 + d] << 16) * kd);
            if (t2 == 0) CD[unit] = s_eg[63];
        }
        LDS_BARRIER();
    }
}

template <bool DUMMY>
__device__ __forceinline__ void gdn_scan_block(const Params& p, int l, int unit, LAS unsigned char* lds) {
    const int tid_ = tid_l(); const int w = __builtin_amdgcn_readfirstlane(tid_ >> 6), lane = tid_ & 63, g = lane >> 4, c = lane & 15;
    const int bh = unit >> 1, eh = unit & 1, b = bh >> 2, h = bh & 3, te = w & 3, rh = w >> 2;
    LAS bf16* ST = (LAS bf16*)lds; LAS bf16* Wb = ST + 64 * 136; LAS bf16* QDb = Wb + 64 * 136; LAS bf16* KDTb = QDb + 64 * 136;
    LAS bf16* AQb = KDTb + 128 * 72; LAS bf16* vnT = AQb + 64 * 72 + w * (16 * 72); LAS bf16* Ub = AQb + 64 * 72 + 8 * 16 * 72;
    const bf16* QD = (const bf16*)(p.ws + WS_QD); const bf16* Wg = (const bf16*)(p.ws + WS_W); const bf16* Ug = (const bf16*)(p.ws + WS_U);
    const bf16* KDT = (const bf16*)(p.ws + WS_KDT); const bf16* AQK = (const bf16*)(p.ws + WS_AQK); const float* CD = (const float*)(p.ws + WS_CD);
    bf16* Uraw = (bf16*)(p.ws + (DUMMY ? WS_KDT : WS_U));
    for (int i = tid_; i < 64 * 136 / 2; i += NTHR) ((LAS unsigned*)ST)[i] = 0u;
    f32x4 S[4];
#pragma unroll
    for (int j = 0; j < 4; ++j) S[j] = (f32x4){0.f, 0.f, 0.f, 0.f};
    u32x4 rW[2], rQ[2], rK[2], rA, rU; float cdn;
#define GDN_FETCH(n_) do { const size_t m0_ = (size_t)b * SEQ + (n_) * 64; const size_t unit_ = (size_t)bh * 32 + (n_); \
        _Pragma("unroll") for (int k_ = 0; k_ < 2; ++k_) { const int idx_ = tid_ + NTHR * k_; const size_t go_ = (m0_ + (idx_ >> 4)) * 512 + h * 128 + 8 * (idx_ & 15); \
            rW[k_] = *(const u32x4*)(Wg + go_); rQ[k_] = *(const u32x4*)(QD + go_); \
            rK[k_] = *(const u32x4*)(KDT + (unit_ * 128 + (idx_ >> 3)) * 64 + 8 * (idx_ & 7)); } \
        rU = *(const u32x4*)(Ug + (m0_ + (tid_ >> 3)) * 512 + h * 128 + 64 * eh + 8 * (tid_ & 7)); \
        rA = *(const u32x4*)(AQK + (unit_ * 64 + (tid_ >> 3)) * 64 + 8 * (tid_ & 7)); cdn = CD[unit_]; } while (0)
#define LDSFENCE() asm volatile("s_waitcnt lgkmcnt(0)" ::: "memory")
    GDN_FETCH(0);
    for (int n = 0; n < 32; ++n) {
        const size_t m0 = (size_t)b * SEQ + n * 64;
#pragma unroll
        for (int k = 0; k < 2; ++k) { const int idx = tid_ + NTHR * k; const int lo = (idx >> 4) * 136 + 8 * (idx & 15);
            *(LAS u32x4*)(Wb + lo) = rW[k]; *(LAS u32x4*)(QDb + lo) = rQ[k];
            *(LAS u32x4*)(KDTb + (idx >> 3) * 72 + 8 * (idx & 7)) = rK[k]; }
        *(LAS u32x4*)(Ub + (tid_ >> 3) * 72 + 8 * (tid_ & 7)) = rU;
        *(LAS u32x4*)(AQb + (tid_ >> 3) * 72 + 8 * (tid_ & 7)) = rA;
        const float cd = cdn;
        LDS_BARRIER();
        if (n + 1 < 32) GDN_FETCH(n + 1);
        bf16x8_t stf[4], af[4][4];
#pragma unroll
        for (int ks = 0; ks < 4; ++ks) stf[ks] = *(const LAS bf16x8_t*)(ST + (16 * te + c) * 136 + 32 * ks + 8 * g);
#pragma unroll
        for (int tc = 0; tc < 4; ++tc)
#pragma unroll
            for (int ks = 0; ks < 4; ++ks) af[tc][ks] = *(const LAS bf16x8_t*)(Wb + (16 * tc + c) * 136 + 32 * ks + 8 * g);
        float uv[4][4];
#pragma unroll
        for (int tc = 0; tc < 4; ++tc)
#pragma unroll
            for (int i = 0; i < 4; ++i) uv[tc][i] = __uint_as_float((unsigned)Ub[(16 * tc + 4 * g + i) * 72 + 16 * te + c] << 16);
        LDSFENCE();
#pragma unroll
        for (int tc = 0; tc < 4; ++tc) {
            f32x4 acc = (f32x4){0.f, 0.f, 0.f, 0.f};
#pragma unroll
            for (int ks = 0; ks < 4; ++ks) acc = __builtin_amdgcn_mfma_f32_16x16x32_bf16(af[tc][ks], stf[ks], acc, 0, 0, 0);
            u32x2 o; o.x = pk2(uv[tc][0] - acc[0], uv[tc][1] - acc[1]); o.y = pk2(uv[tc][2] - acc[2], uv[tc][3] - acc[3]);
            *(LAS u32x2*)(vnT + c * 72 + 16 * tc + 4 * g) = o;
        }
        bf16x8_t vf[2], qf[2][2];
#pragma unroll
        for (int t2 = 0; t2 < 2; ++t2)
#pragma unroll
            for (int ks = 0; ks < 4; ++ks) af[t2][ks] = *(const LAS bf16x8_t*)(QDb + (16 * (2 * rh + t2) + c) * 136 + 32 * ks + 8 * g);
#pragma unroll
        for (int t2 = 0; t2 < 2; ++t2)
#pragma unroll
            for (int ks = 0; ks < 2; ++ks) qf[t2][ks] = *(const LAS bf16x8_t*)(AQb + (16 * (2 * rh + t2) + c) * 72 + 32 * ks + 8 * g);
#pragma unroll
        for (int ks = 0; ks < 2; ++ks) vf[ks] = *(const LAS bf16x8_t*)(vnT + c * 72 + 32 * ks + 8 * g);
        LDSFENCE();
        f32x4 ot[2];
#pragma unroll
        for (int t2 = 0; t2 < 2; ++t2) {
            f32x4 acc = (f32x4){0.f, 0.f, 0.f, 0.f};
#pragma unroll
            for (int ks = 0; ks < 4; ++ks) acc = __builtin_amdgcn_mfma_f32_16x16x32_bf16(af[t2][ks], stf[ks], acc, 0, 0, 0);
#pragma unroll
            for (int ks = 0; ks < 2; ++ks) acc = __builtin_amdgcn_mfma_f32_16x16x32_bf16(qf[t2][ks], vf[ks], acc, 0, 0, 0);
            ot[t2] = acc;
        }
#pragma unroll
        for (int t2 = 0; t2 < 2; ++t2)
#pragma unroll
            for (int i = 0; i < 4; ++i) Uraw[(m0 + 16 * (2 * rh + t2) + 4 * g + i) * 512 + h * 128 + 64 * eh + 16 * te + c] = (bf16)f2bf(ot[t2][i]);
        bf16x8_t kf[4][2];
#pragma unroll
        for (int j = 0; j < 4; ++j)
#pragma unroll
            for (int ks = 0; ks < 2; ++ks) kf[j][ks] = *(const LAS bf16x8_t*)(KDTb + (16 * (4 * rh + j) + c) * 72 + 32 * ks + 8 * g);
        LDSFENCE();
#pragma unroll
        for (int j = 0; j < 4; ++j) {
            f32x4 acc = S[j] * cd;
#pragma unroll
            for (int ks = 0; ks < 2; ++ks) acc = __builtin_amdgcn_mfma_f32_16x16x32_bf16(kf[j][ks], vf[ks], acc, 0, 0, 0);
            S[j] = acc;
        }
        LDS_BARRIER();
#pragma unroll
        for (int j = 0; j < 4; ++j) { u32x2 o; o.x = pk2(S[j][0], S[j][1]); o.y = pk2(S[j][2], S[j][3]);
            *(LAS u32x2*)(ST + (16 * te + c) * 136 + 16 * (4 * rh + j) + 4 * g) = o; }
        LDS_BARRIER();
    }
#undef LDSFENCE
#undef GDN_FETCH
}

__device__ __forceinline__ void hgrn_scan_block(const Params& p, int l, int unit, LAS unsigned char* lds) {
    const int tid_ = tid_l(); const int w = __builtin_amdgcn_readfirstlane(tid_ >> 6), lane = tid_ & 63, tt = lane >> 2, dd = lane & 3;
    const int bh = unit >> 2, dq = unit & 3, b = bh >> 2, h = bh & 3; const size_t m0 = (size_t)b * SEQ;
    LAS float* coef = (LAS float*)lds + (w & 3) * (32 * 12);
    LAS float* part = (LAS float*)(lds + 8192);
    LAS bf16* vst = (LAS bf16*)(lds + 8192 + 65536);
    LAS bf16* qst = vst + 2 * 128 * 64;
    LAS bf16* fst = qst + 2 * 128 * 16;
    const bf16* PROJ = (const bf16*)(p.ws + WS_PROJ);
    bf16* OUT = dq == 0 ? (bf16*)(p.ws + WS_H) + m0 * D + 768 + h * 64 + lane
              : (dq == 3 ? (bf16*)(p.ws + WS_P3) : (bf16*)(p.ws + WS_OMIX) + (size_t)(dq - 1) * M * 256) + m0 * 256 + h * 64 + lane;
    const int opitch = dq ? 256 : D;
    const int dcol = h * 64 + 16 * dq + 4 * (w & 3) + dd;
    float lb = 0.f;
    if (l == 1) lb = 1.0f / (1.0f + expf(p.in[13][dcol] - p.in[13][256 + dcol]));
    f32x2 S2[2]; S2[0] = (f32x2){0.f, 0.f}; S2[1] = (f32x2){0.f, 0.f};
    u32x4 rv[2], rq;
    const bf16* gq = PROJ + m0 * NPROJ + (tid_ < 256 ? PC_HQ : PC_HF) + h * 64 + 16 * dq + 8 * (tid_ & 1);
#define HG_FETCH(sg_) do { const size_t t0_ = (size_t)(sg_) * 128; \
        _Pragma("unroll") for (int k_ = 0; k_ < 2; ++k_) { const int idx_ = tid_ + NTHR * k_; rv[k_] = *(const u32x4*)(PROJ + (m0 + t0_ + (idx_ >> 3)) * NPROJ + PC_HI + h * 64 + 8 * (idx_ & 7)); } \
        rq = *(const u32x4*)(gq + (t0_ + ((tid_ & 255) >> 1)) * NPROJ); } while (0)
#define HG_STAGE(sb_) do { \
        _Pragma("unroll") for (int k_ = 0; k_ < 2; ++k_) { const int idx_ = tid_ + NTHR * k_; *(LAS u32x4*)(vst + (sb_) * 128 * 64 + (idx_ >> 3) * 64 + 8 * (idx_ & 7)) = rv[k_]; } \
        *(LAS u32x4*)((tid_ < 256 ? qst : fst) + (sb_) * 128 * 16 + ((tid_ & 255) >> 1) * 16 + 8 * (tid_ & 1)) = rq; } while (0)
    unsigned ypend[8] = {0u, 0u, 0u, 0u, 0u, 0u, 0u, 0u};
    HG_FETCH(0);
    HG_STAGE(0);
    LDS_BARRIER();
    for (int sg = 0; sg < SEQ / 128; ++sg) {
        const int sb = sg & 1;
        if (sg + 1 < SEQ / 128) HG_FETCH(sg + 1);
        for (int g4 = 0; g4 < 4; ++g4) {
            const int grp = sg * 4 + g4, buf = grp & 1, r0 = g4 * 32;
            if (w < 4) {
                if (grp > 0) {
#pragma unroll
                    for (int k = 0; k < 8; ++k) OUT[(size_t)((grp - 1) * 32 + 8 * w + k) * opitch] = (bf16)ypend[k];
                }
#pragma unroll
                for (int hh = 0; hh < 2; ++hh) {
                    const int tq = tt + 16 * hh;
                    const float hq = __uint_as_float((unsigned)qst[sb * 128 * 16 + (r0 + tq) * 16 + 4 * w + dd] << 16), fp = __uint_as_float((unsigned)fst[sb * 128 * 16 + (r0 + tq) * 16 + 4 * w + dd] << 16);
                    const float en = __expf(-fabsf(fp)), rd = __builtin_amdgcn_rcpf(1.0f + en), sg_ = fp >= 0.f ? rd : en * rd, sn = fp >= 0.f ? en * rd : rd;
                    LAS float* cr = coef + tq * 12 + dd;
                    cr[0] = lb + (1.0f - lb) * sg_; cr[4] = (1.0f - lb) * sn; cr[8] = silu(hq); }
                float pacc[32];
#pragma unroll
                for (int hs = 0; hs < 4; ++hs) {
                    unsigned vraw[8];
#pragma unroll
                    for (int s = 0; s < 8; ++s) vraw[s] = vst[sb * 128 * 64 + (r0 + 8 * hs + s) * 64 + lane];
                    f32x4 cf[8], ck[8], cq[8];
#pragma unroll
                    for (int s = 0; s < 8; ++s) { const LAS f32x4* cs = (const LAS f32x4*)(coef + (8 * hs + s) * 12); cf[s] = cs[0]; ck[s] = cs[1]; cq[s] = cs[2]; }
#pragma unroll
                    for (int s = 0; s < 8; ++s) {
                        const float vv = __uint_as_float(vraw[s] << 16); const f32x2 v2 = (f32x2){vv, vv};
                        S2[0] = S2[0] * (f32x2){cf[s].x, cf[s].y} + (f32x2){ck[s].x, ck[s].y} * v2; S2[1] = S2[1] * (f32x2){cf[s].z, cf[s].w} + (f32x2){ck[s].z, ck[s].w} * v2;
                        const f32x2 p2 = (f32x2){cq[s].x, cq[s].y} * S2[0] + (f32x2){cq[s].z, cq[s].w} * S2[1];
                        pacc[8 * hs + s] = p2.x + p2.y;
                    }
                }
#pragma unroll
                for (int s = 0; s < 32; ++s) part[((buf * 4 + w) * 32 + s) * 64 + lane] = pacc[s];
            }
            LDS_BARRIER();
            if (w < 4) {
#pragma unroll
                for (int k = 0; k < 8; ++k) { const int s = 8 * w + k; float o = 0.f;
#pragma unroll
                    for (int ww = 0; ww < 4; ++ww) o += part[((buf * 4 + ww) * 32 + s) * 64 + lane];
                    ypend[k] = f2bf(o); }
            }
        }
        if (sg + 1 < SEQ / 128) { HG_STAGE(sb ^ 1); LDS_BARRIER(); }
    }
    if (w < 4) {
#pragma unroll
        for (int k = 0; k < 8; ++k) OUT[(size_t)((SEQ / 32 - 1) * 32 + 8 * w + k) * opitch] = (bf16)ypend[k];
    }
#undef HG_STAGE
#undef HG_FETCH
}

__device__ __forceinline__ void sb_tile_wave(const Params& p, int l, int task, int lane) {
    const bf16* PROJ = (const bf16*)(p.ws + WS_PROJ); const bf16* VT = (const bf16*)(p.ws + WS_VT); bf16* O = (bf16*)(p.ws + WS_H);
    const int bh = task >> 7, qt = task & 127, b = bh >> 2, h = bh & 3, t0 = qt * 16, g = lane >> 4, c = lane & 15;
    const size_t mb = (size_t)b * SEQ;
    bf16x8_t qfrag[2];
#pragma unroll
    for (int ks = 0; ks < 2; ++ks) qfrag[ks] = *(const bf16x8_t*)(PROJ + (mb + t0 + c) * NPROJ + PC_SBQ + h * 64 + 32 * ks + 8 * g);
    f32x4 oacc[4];
#pragma unroll
    for (int dt = 0; dt < 4; ++dt) oacc[dt] = (f32x4){0.f, 0.f, 0.f, 0.f};
    float carry = 0.f;
    const int tq = t0 + c;
    for (int kb = (t0 + 14) >> 5; kb >= 0; --kb) {
        const int k0 = 32 * kb;
        float w[2][4];
#pragma unroll
        for (int jj = 0; jj < 2; ++jj) {
            const int j = 1 - jj;
            f32x4 acc = (f32x4){0.f, 0.f, 0.f, 0.f};
#pragma unroll
            for (int ks = 0; ks < 2; ++ks) { const bf16x8_t kf = *(const bf16x8_t*)(PROJ + (mb + k0 + 16 * j + c) * NPROJ + PC_SBK + h * 64 + 32 * ks + 8 * g);
                acc = __builtin_amdgcn_mfma_f32_16x16x32_bf16(kf, qfrag[ks], acc, 0, 0, 0); }
            float lk[4], ls[4]; bool valid[4];
#pragma unroll
            for (int i = 0; i < 4; ++i) { const float z = acc[i] * 0.125f; valid[i] = (k0 + 16 * j + 4 * g + i) < tq;
                const float sp = fmaxf(z, 0.f) + __logf(1.0f + __expf(-fabsf(z))); lk[i] = valid[i] ? -sp : 0.f; ls[i] = z - sp; }
            const float suf2 = lk[3], suf1 = lk[3] + lk[2], suf0 = suf1 + lk[1], T = suf0 + lk[0];
            const float T1 = __shfl_down(T, 16), T2 = __shfl_down(T, 32), T3 = __shfl_down(T, 48);
            const float E = (g < 3 ? T1 : 0.f) + (g < 2 ? T2 : 0.f) + (g < 1 ? T3 : 0.f);
            const float Ttot = __shfl(T + E, c);
            const float base = carry + E;
            w[j][0] = valid[0] ? __expf(ls[0] + base + suf0) : 0.f; w[j][1] = valid[1] ? __expf(ls[1] + base + suf1) : 0.f;
            w[j][2] = valid[2] ? __expf(ls[2] + base + suf2) : 0.f; w[j][3] = valid[3] ? __expf(ls[3] + base) : 0.f;
            carry += Ttot;
        }
        u32x4 pu; pu.x = pk2(w[0][0], w[0][1]); pu.y = pk2(w[0][2], w[0][3]); pu.z = pk2(w[1][0], w[1][1]); pu.w = pk2(w[1][2], w[1][3]);
        const bf16x8_t pfrag = __builtin_bit_cast(bf16x8_t, pu);
#pragma unroll
        for (int dt = 0; dt < 4; ++dt) { const bf16* vr = VT + ((size_t)bh * 64 + 16 * dt + c) * SEQ + k0 + 4 * g;
            const u32x2 v0 = *(const u32x2*)vr, v1 = *(const u32x2*)(vr + 16);
            u32x4 vu; vu.x = v0.x; vu.y = v0.y; vu.z = v1.x; vu.w = v1.y;
            oacc[dt] = __builtin_amdgcn_mfma_f32_16x16x32_bf16(__builtin_bit_cast(bf16x8_t, vu), pfrag, oacc[dt], 0, 0, 0); }
        if (__all(carry < -90.0f)) break;
    }
    float ss = 0.f;
#pragma unroll
    for (int dt = 0; dt < 4; ++dt) ss += (oacc[dt][0] * oacc[dt][0] + oacc[dt][1] * oacc[dt][1]) + (oacc[dt][2] * oacc[dt][2] + oacc[dt][3] * oacc[dt][3]);
    ss += __shfl_xor(ss, 16); ss += __shfl_xor(ss, 32);
    const float r = __builtin_amdgcn_rsqf(ss * (1.0f / 64.0f) + EPS);
#pragma unroll
    for (int dt = 0; dt < 4; ++dt) { const f32x4 gn = *(const f32x4*)(p.in[10] + l * 64 + 16 * dt + 4 * g);
        u32x2 o; o.x = pk2(oacc[dt][0] * r * gn.x, oacc[dt][1] * r * gn.y); o.y = pk2(oacc[dt][2] * r * gn.z, oacc[dt][3] * r * gn.w);
        *(u32x2*)(O + (mb + tq) * D + h * 64 + 16 * dt + 4 * g) = o; }
}

__device__ __forceinline__ void phase_scan(const Params& p, int l, LAS unsigned char* lds) {
    if (blockIdx.x < 64) { gdn_scan_block<false>(p, l, blockIdx.x, lds);
#if PROBE == 4
        gdn_scan_block<true>(p, l, blockIdx.x, lds);
#endif
    } else if (blockIdx.x < 192) { hgrn_scan_block(p, l, blockIdx.x - 64, lds);
#if PROBE == 5
        LDS_BARRIER(); hgrn_scan_block(p, l, blockIdx.x - 64, lds);
#endif
    }
    const int tid_ = tid_l(); const int lane = tid_ & 63;
    unsigned* ctr = (unsigned*)(p.ws + WS_TASK) + 64 * l;
    for (;;) {
        unsigned t = 0u;
        if (lane == 0) t = __hip_atomic_fetch_add(ctr, 1u, __ATOMIC_RELAXED, __HIP_MEMORY_SCOPE_AGENT);
        const int task = __builtin_amdgcn_readfirstlane((int)t);
        if (task >= 4096) break;
        sb_tile_wave(p, l, task, lane);
#if PROBE == 6
        sb_tile_wave(p, l, task, lane);
#endif
    }
}

__device__ __forceinline__ void phase_post(const Params& p, int l) {
    const int tid_ = tid_l(); const int wave = __builtin_amdgcn_readfirstlane(tid_ >> 6), lane = tid_ & 63;
    const int gw = blockIdx.x * NWAVES + wave, NGW = gridDim.x * NWAVES;
    const bf16* PROJ = (const bf16*)(p.ws + WS_PROJ); const bf16* P1 = (const bf16*)(p.ws + WS_OMIX); const bf16* Uraw = (const bf16*)(p.ws + WS_U); bf16* O = (bf16*)(p.ws + WS_H);
    const f32x2 gg = *(const f32x2*)(p.in[11] + l * 128 + 2 * lane);
    const f32x4 hg = *(const f32x4*)(p.in[12] + l * 64 + ((4 * lane) & 63));
    for (int m = gw; m < M; m += NGW) {
        unsigned uo[4], uz[4];
#pragma unroll
        for (int h = 0; h < 4; ++h) { uo[h] = *(const unsigned*)(Uraw + (size_t)m * 512 + h * 128 + 2 * lane); uz[h] = *(const unsigned*)(PROJ + (size_t)m * NPROJ + PC_GZ + h * 128 + 2 * lane); }
        const u32x2 a0 = *(const u32x2*)(O + (size_t)m * D + 768 + 4 * lane), a1 = *(const u32x2*)(P1 + (size_t)m * 256 + 4 * lane), a2 = *(const u32x2*)(P1 + ((size_t)M + m) * 256 + 4 * lane), a3 = *(const u32x2*)((const bf16*)(p.ws + WS_P3) + (size_t)m * 256 + 4 * lane), ug = *(const u32x2*)(PROJ + (size_t)m * NPROJ + PC_HG + 4 * lane);
#pragma unroll
        for (int h = 0; h < 4; ++h) { const float o0 = bflo(uo[h]), o1 = bfhi(uo[h]);
            const float r = __builtin_amdgcn_rsqf(wave_sum_fast(o0 * o0 + o1 * o1) * (1.0f / 128.0f) + EPS);
            *(unsigned*)(O + (size_t)m * D + 256 + h * 128 + 2 * lane) = pk2(o0 * r * gg.x * silu(bflo(uz[h])), o1 * r * gg.y * silu(bfhi(uz[h]))); }
        const float x0 = (bflo(a0.x) + bflo(a1.x)) + (bflo(a2.x) + bflo(a3.x)), x1 = (bfhi(a0.x) + bfhi(a1.x)) + (bfhi(a2.x) + bfhi(a3.x)), x2 = (bflo(a0.y) + bflo(a1.y)) + (bflo(a2.y) + bflo(a3.y)), x3 = (bfhi(a0.y) + bfhi(a1.y)) + (bfhi(a2.y) + bfhi(a3.y));
        float ss = (x0 * x0 + x1 * x1) + (x2 * x2 + x3 * x3);
        ss += dpp_mov<0xB1>(ss); ss += dpp_mov<0x4E>(ss); ss += dpp_mov<0x141>(ss); ss += dpp_mov<0x140>(ss);
        const float r = __builtin_amdgcn_rsqf(ss * (1.0f / 64.0f) + EPS);
        u32x2 wv; wv.x = pk2(x0 * r * hg.x * silu(bflo(ug.x)), x1 * r * hg.y * silu(bfhi(ug.x))); wv.y = pk2(x2 * r * hg.z * silu(bflo(ug.y)), x3 * r * hg.w * silu(bfhi(ug.y)));
        *(u32x2*)(O + (size_t)m * D + 768 + 4 * lane) = wv;
    }
}

#define RLX_AGENT __ATOMIC_RELAXED, __HIP_MEMORY_SCOPE_AGENT
#define XB_TMO      128
#define XB_XCNT(j)  (256  + 64 * (j))
#define XB_XSUB(j)  (1280 + 64 * (j))
#define XB_XGEN(j)  (2304 + 64 * (j))
#define XB_TOP      3328
#define XB_TOPGEN   3392
#define XCD_BAR_WORDS 3456
#define XB_SPIN_CAP (1u << 18)

__device__ __forceinline__ unsigned xb_ld(unsigned* p)              { return __hip_atomic_load(p, __ATOMIC_RELAXED, __HIP_MEMORY_SCOPE_AGENT); }
__device__ __forceinline__ unsigned xb_add(unsigned* p, unsigned v) { return __hip_atomic_fetch_add(p, v, __ATOMIC_RELAXED, __HIP_MEMORY_SCOPE_AGENT); }
__device__ __forceinline__ unsigned xb_xcc_id() { return (unsigned)__builtin_amdgcn_s_getreg((3 << 11) | 20) & 0xFu; }
#define XB_SPIN(cond, bar) do { unsigned _sp = 0; while (cond) { __builtin_amdgcn_s_sleep(1); \
    if ((++_sp & 255u) == 0u) { if (xb_ld(&(bar)[XB_TMO])) break; if (_sp > XB_SPIN_CAP) { atomicAdd(&(bar)[XB_TMO], 1u); break; } } } } while (0)

struct XcdBarrier {
    unsigned* bar; unsigned x;
    volatile LAS unsigned* st;
};

__device__ __forceinline__ XcdBarrier xcd_barrier_post(unsigned* bar, volatile LAS unsigned* st) {
    XcdBarrier b; b.bar = bar; b.x = xb_xcc_id(); b.st = st;
    if (threadIdx.x == 0) (void)xb_add(&bar[XB_XCNT(b.x)], 1u);
    return b;
}
__device__ __forceinline__ void xcd_barrier_complete(unsigned* bar, unsigned x, unsigned& nloc, unsigned& nx) {
    const unsigned G = gridDim.x * gridDim.y * gridDim.z;
    unsigned sum, cnt, mine, sp = 0u;
    for (;;) {
        sum = 0u; cnt = 0u; mine = 0u;
#pragma unroll
        for (unsigned j = 0; j < 16; ++j) { const unsigned c = xb_ld(&bar[XB_XCNT(j)]); sum += c; cnt += (c > 0u) ? 1u : 0u; mine = (j == x) ? c : mine; }
        if (sum == G) break;
        __builtin_amdgcn_s_sleep(1);
        if ((++sp & 255u) == 0u) { if (xb_ld(&bar[XB_TMO])) break; if (sp > XB_SPIN_CAP) { atomicAdd(&bar[XB_TMO], 1u); break; } }
    }
    nloc = mine > 0u ? mine : 1u; nx = cnt > 0u ? cnt : 1u;
}

__device__ __forceinline__ void xcd_barrier(const XcdBarrier& b) {
    asm volatile("s_waitcnt vmcnt(0)" ::: "memory");
    __syncthreads();
    if (threadIdx.x == 0) {
        unsigned* bar = b.bar;
        __builtin_amdgcn_s_waitcnt(0);
        unsigned nloc = b.st[0], nx = b.st[1];
        if (nloc == 0u) { xcd_barrier_complete(bar, b.x, nloc, nx); b.st[0] = nloc; b.st[1] = nx; }
        const unsigned old = xb_add(&bar[XB_XSUB(b.x)], 1u);
        const unsigned gen = old / nloc;
        if (old + 1u == (gen + 1u) * nloc) {
            __builtin_amdgcn_fence(__ATOMIC_RELEASE, "agent");
            asm volatile("s_waitcnt vmcnt(0)" ::: "memory");
            const unsigned og = xb_add(&bar[XB_TOP], 1u);
            const unsigned tg = og / nx;
            if (og + 1u == (tg + 1u) * nx) xb_add(&bar[XB_TOPGEN], 1u);
            else XB_SPIN(xb_ld(&bar[XB_TOPGEN]) == tg, bar);
            __builtin_amdgcn_fence(__ATOMIC_ACQUIRE, "agent");
            xb_add(&bar[XB_XGEN(b.x)], 1u);
            asm volatile("s_waitcnt vmcnt(0)" ::: "memory");
        } else {
            XB_SPIN(xb_ld(&bar[XB_XGEN(b.x)]) == gen, bar);
            __builtin_amdgcn_fence(__ATOMIC_ACQUIRE, "agent");
            asm volatile("s_waitcnt vmcnt(0)" ::: "memory");
        }
    }
    __syncthreads();
}

__global__ void __launch_bounds__(NTHR, 2) fwd_megakernel(Params p) {
    extern __shared__ __attribute__((aligned(16))) unsigned char lds_raw[];
    LAS unsigned char* lds = (LAS unsigned char*)lds_raw;
    cg::grid_group grid = cg::this_grid();
#define GRID_SYNC() do { asm volatile("s_waitcnt vmcnt(0) lgkmcnt(0)" ::: "memory"); grid.sync(); __builtin_amdgcn_fence(__ATOMIC_ACQUIRE, "agent"); asm volatile("s_waitcnt vmcnt(0)" ::: "memory"); } while (0)
    unsigned char* ws = p.ws;
    volatile LAS unsigned* bst = (volatile LAS unsigned*)(lds + LDS_BYTES - 16);
    if (threadIdx.x == 0) { bst[0] = 0u; bst[1] = 0u; }
    __syncthreads();
    const XcdBarrier xbar = xcd_barrier_post((unsigned*)(ws + WS_BAR), bst);
#define XSYNC() xcd_barrier(xbar)
    const float* MOD = (const float*)(ws + WS_MOD);
    bf16* H = (bf16*)(ws + WS_H); bf16* ACT = (bf16*)(ws + WS_PROJ); bf16* PROJ = (bf16*)(ws + WS_PROJ);
    float* X = p.out;

    phase_ada(p, lds);
    phase_convert(p, 0, lds);
    GRID_SYNC();
    for (int l = 0; l < 2; ++l) {
        const float* modl = MOD + (size_t)l * 8 * NMODC;
        const float* Xin = (l == 0) ? p.in[0] : X;
        if (l == 1) phase_convert(p, 1, lds);
        phase_norm<false>(Xin, p.in[2] + l * D, modl + 0 * D, modl + 1 * D, H, nullptr, nullptr, lds);
#if PROBE == 9
        phase_norm<false>(Xin, p.in[2] + l * D, modl + 0 * D, modl + 1 * D, H, nullptr, nullptr, lds);
#endif
        XSYNC();
        { pg8::Gemm g{H, (const bf16*)(ws + WS_W1IN), M, 2 * DFF, D}; pg8::StaticOrder S; S.init(M, 2 * DFF, gridDim.x, blockIdx.x);
          pg8::EpiSwiglu E{ACT, DFF}; pg8::gemm_phase<pg8::EpiSwiglu, pg8::StaticOrder, true, true>(lds, g, S, E); }
        XSYNC();
#if PROBE == 7
        { pg8::Gemm g{H, (const bf16*)(ws + WS_W1IN), M, 2 * DFF, D}; pg8::StaticOrder S; S.init(M, 2 * DFF, gridDim.x, blockIdx.x);
          pg8::EpiSwiglu E{ACT, DFF}; pg8::gemm_phase<pg8::EpiSwiglu, pg8::StaticOrder, true, true>(lds, g, S, E); }
        XSYNC();
#endif
        { pg8::Gemm g{ACT, (const bf16*)(ws + WS_W1OUT), M, D, DFF}; pg8::StaticOrder S; S.init(M, D, gridDim.x, blockIdx.x);
          pg8::EpiResid E{Xin, X, modl + 2 * D, NMODC, 0.5f}; pg8::gemm_phase<pg8::EpiResid, pg8::StaticOrder, true, true>(lds, g, S, E); }
        XSYNC();
        phase_norm<true>(X, p.in[5] + l * D, modl + 3 * D, modl + 4 * D, H, p.in[6] + (size_t)l * 1024 * DIN, (float*)(ws + WS_BA), lds);
#if PROBE == 9
        phase_norm<true>(X, p.in[5] + l * D, modl + 3 * D, modl + 4 * D, H, p.in[6] + (size_t)l * 1024 * DIN, (float*)(ws + WS_BA), lds);
#endif
        XSYNC();
        { pg8::Gemm g{H, (const bf16*)(ws + WS_WMI), M, NPROJ, D}; pg8::StaticOrder S; S.init(M, NPROJ, gridDim.x, blockIdx.x);
          pg8::EpiBf16Plain E{PROJ, NPROJ}; pg8::gemm_phase<pg8::EpiBf16Plain, pg8::StaticOrder, true, true>(lds, g, S, E); }
        XSYNC();
#if PROBE == 8
        { pg8::Gemm g{H, (const bf16*)(ws + WS_WMI), M, NPROJ, D}; pg8::StaticOrder S; S.init(M, NPROJ, gridDim.x, blockIdx.x);
          pg8::EpiBf16Plain E{PROJ, NPROJ}; pg8::gemm_phase<pg8::EpiBf16Plain, pg8::StaticOrder, true, true>(lds, g, S, E); }
        XSYNC();
#endif
        phase_prep(p, l, lds);
        XSYNC();
#if PROBE == 2
        phase_prep(p, l, lds);
        XSYNC();
#endif
#if PROBE == 3
        XSYNC(); XSYNC(); XSYNC(); XSYNC(); XSYNC(); XSYNC(); XSYNC(); XSYNC();
#endif
        phase_scan(p, l, lds);
        XSYNC();
#if PROBE == 1
        phase_scan(p, l, lds);
        XSYNC();
#endif
        phase_post(p, l);
        XSYNC();
        { pg8::Gemm g{H, (const bf16*)(ws + WS_WMO), M, D, D}; pg8::StaticOrder S; S.init(M, D, gridDim.x, blockIdx.x);
          pg8::EpiResid E{X, X, modl + 5 * D, NMODC, 1.0f}; pg8::gemm_phase<pg8::EpiResid, pg8::StaticOrder, true, true>(lds, g, S, E); }
        XSYNC();
        phase_norm<false>(X, p.in[15] + l * D, modl + 6 * D, modl + 7 * D, H, nullptr, nullptr, lds);
#if PROBE == 9
        phase_norm<false>(X, p.in[15] + l * D, modl + 6 * D, modl + 7 * D, H, nullptr, nullptr, lds);
#endif
        XSYNC();
        { pg8::Gemm g{H, (const bf16*)(ws + WS_W2IN), M, 2 * DFF, D}; pg8::StaticOrder S; S.init(M, 2 * DFF, gridDim.x, blockIdx.x);
          pg8::EpiSwiglu E{ACT, DFF}; pg8::gemm_phase<pg8::EpiSwiglu, pg8::StaticOrder, true, true>(lds, g, S, E); }
        XSYNC();
        { pg8::Gemm g{ACT, (const bf16*)(ws + WS_W2OUT), M, D, DFF}; pg8::StaticOrder S; S.init(M, D, gridDim.x, blockIdx.x);
          pg8::EpiResid E{X, X, modl + 8 * D, NMODC, 0.5f}; pg8::gemm_phase<pg8::EpiResid, pg8::StaticOrder, true, true>(lds, g, S, E); }
        XSYNC();
    }
    phase_final(X, p.in[20]);
}

extern "C" void kernel_launch(void* const* d_in, const int* in_sizes, int n_in, void* d_out, int out_size, void* d_ws, size_t ws_size, hipStream_t stream) {
    static int grid = 0;
    if (grid == 0) {
        if (n_in != 21 || out_size != M * D || ws_size < WS_END) { fprintf(stderr, "kernel_launch: unexpected shapes: n_in %d out %d ws %zu (need %zu)\n", n_in, out_size, ws_size, (size_t)WS_END); grid = -1; return; }
        int dev = 0, cus = 0, per_cu = 0;
        hipGetDevice(&dev);
        hipDeviceGetAttribute(&cus, hipDeviceAttributeMultiprocessorCount, dev);
        hipFuncSetAttribute((const void*)fwd_megakernel, hipFuncAttributeMaxDynamicSharedMemorySize, LDS_BYTES);
        hipOccupancyMaxActiveBlocksPerMultiprocessor(&per_cu, (const void*)fwd_megakernel, NTHR, LDS_BYTES);
        if (per_cu < 1) { fprintf(stderr, "kernel_launch: occupancy query says %d blocks per CU\n", per_cu); per_cu = 1; }
        grid = cus * 1;
        (void)hipGetLastError();
    }
    if (grid < 0) return;
    hipMemsetAsync((char*)d_ws + WS_MOD, 0, ZERO_BYTES, stream);
    Params p{};
    for (int i = 0; i < 21; ++i) p.in[i] = (const float*)d_in[i];
    p.out = (float*)d_out; p.ws = (unsigned char*)d_ws;
    void* args[] = {&p};
    hipError_t e = hipLaunchCooperativeKernel((const void*)fwd_megakernel, dim3(grid), dim3(NTHR), args, LDS_BYTES, stream);
    if (e != hipSuccess) fprintf(stderr, "cooperative launch failed: %s (grid %d)\n", hipGetErrorString(e), grid);
}
```

```cpp
#include <hip/hip_runtime.h>
#include <hip/hip_cooperative_groups.h>
#include <cstdio>
#include <cstdint>
namespace cg = cooperative_groups;
#ifndef PROBE
#define PROBE 0
#endif
__device__ __forceinline__ int tid_l() { int t = threadIdx.x; asm volatile("" : "+v"(t)); return t; }
namespace pg8 {
#define PG8_LAS __attribute__((address_space(3)))
typedef unsigned short bf16_t;
typedef short bf16x8 __attribute__((ext_vector_type(8)));
typedef float f32x4 __attribute__((ext_vector_type(4)));
typedef unsigned u32x4 __attribute__((ext_vector_type(4)));
constexpr int BM = 256, BK = 64, HALF = 128, HTB = HALF * BK * 2  , STAGE_BYTES = 8 * HTB, NXCD = 8, WGM = 8;

__host__ __device__ __forceinline__ int lds_byte(int r, int c) { const int st = (r >> 4) * 2 + (c >> 5), rr = r & 15, cc = c & 31, ob = rr * 64 + cc * 2; return st * 1024 + (ob ^ (((ob >> 9) & 1) << 5)); }
__host__ __device__ __forceinline__ void stage_rc(int b, int& R, int& C) { const int st = b / 1024, sb = b % 1024, swz = sb ^ (((sb >> 9) & 1) << 5); R = (st >> 1) * 16 + swz / 64; C = (st & 1) * 32 + (swz % 64) / 2; }
__host__ __device__ __forceinline__ int perm32(int rho) { const int n = rho >> 4, i = rho & 15; return 8 * (i >> 2) + 4 * n + (i & 3); }

struct Unit { int pm, pn; };
struct Gemm { const bf16_t* A; const bf16_t* Bt; int M, N, K; };

struct StaticOrder {
    int nM, nN, nwg, G, c;
    __host__ __device__ void init(int M, int N, int G_, int c_) { nM = M / BM; nN = N / BM; nwg = nM * nN; G = G_; c = c_; }
    __host__ __device__ bool next(int i, Unit& u) const {
        const long L = (long)i * G + c; if (L >= nwg) return false;
        int wgid = (int)L; { const int q = nwg / NXCD, r = nwg % NXCD, xcd = wgid % NXCD, off = wgid / NXCD; wgid = (xcd < r ? xcd * (q + 1) : r * (q + 1) + (xcd - r) * q) + off; }
        const int nig = WGM * nN, gid = wgid / nig, fm = gid * WGM, gsz = (nM - fm) < WGM ? (nM - fm) : WGM;
        u.pm = fm + ((wgid % nig) % gsz); u.pn = (wgid % nig) / gsz; return true;
    }
    __device__ __forceinline__ void a_ready(const Unit&) const {}
    __device__ __forceinline__ void done(const Unit&) const {}
};

typedef __bf16 bf16x2n_t __attribute__((ext_vector_type(2)));
typedef float f32x2n_t __attribute__((ext_vector_type(2)));
__device__ __forceinline__ unsigned cvt_pk_bf16(float lo, float hi) { const f32x2n_t v = {lo, hi}; return __builtin_bit_cast(unsigned, __builtin_convertvector(v, bf16x2n_t)); }
typedef float f32x2 __attribute__((ext_vector_type(2)));
__device__ __forceinline__ float silu_f(float g) { return g * __builtin_amdgcn_rcpf(1.0f + __expf(-g)); }
struct EpiBf16Plain {
    static constexpr bool PERM = true, AFTER_DRAIN = false;
    bf16_t* O; int ldc;
    __device__ __forceinline__ void operator()(const f32x4 (&acc)[2][2][4][2], const Unit& u, int wr, int wc, int fr, int fq) const {
        const int row0 = u.pm * BM + wr * 64 + fr, col0 = u.pn * BM + wc * 32 + 8 * fq;
#pragma unroll
        for (int ai = 0; ai < 2; ++ai)
#pragma unroll
            for (int m = 0; m < 4; ++m) { bf16_t* rowp = O + (size_t)(row0 + ai * HALF + m * 16) * ldc + col0;
#pragma unroll
                for (int bj = 0; bj < 2; ++bj) { const f32x4 v0 = acc[ai][bj][m][0], v1 = acc[ai][bj][m][1];
                    u32x4 w; w.x = cvt_pk_bf16(v0[0], v0[1]); w.y = cvt_pk_bf16(v0[2], v0[3]); w.z = cvt_pk_bf16(v1[0], v1[1]); w.w = cvt_pk_bf16(v1[2], v1[3]);
                    *(u32x4*)(rowp + bj * HALF) = w; } }
    }
};
struct EpiSwiglu {
    static constexpr bool PERM = true, AFTER_DRAIN = false;
    bf16_t* O; int ldc;
    __device__ __forceinline__ void operator()(const f32x4 (&acc)[2][2][4][2], const Unit& u, int wr, int wc, int fr, int fq) const {
        const int row0 = u.pm * BM + wr * 64 + fr, col0 = u.pn * HALF + wc * 32 + 8 * fq;
#pragma unroll
        for (int ai = 0; ai < 2; ++ai)
#pragma unroll
            for (int m = 0; m < 4; ++m) { bf16_t* rowp = O + (size_t)(row0 + ai * HALF + m * 16) * ldc + col0;
                const f32x4 g0 = acc[ai][0][m][0], g1 = acc[ai][0][m][1], u0 = acc[ai][1][m][0], u1 = acc[ai][1][m][1];
                u32x4 w;
                w.x = cvt_pk_bf16(silu_f(g0[0]) * u0[0], silu_f(g0[1]) * u0[1]); w.y = cvt_pk_bf16(silu_f(g0[2]) * u0[2], silu_f(g0[3]) * u0[3]);
                w.z = cvt_pk_bf16(silu_f(g1[0]) * u1[0], silu_f(g1[1]) * u1[1]); w.w = cvt_pk_bf16(silu_f(g1[2]) * u1[2], silu_f(g1[3]) * u1[3]);
                *(u32x4*)rowp = w; }
    }
};
struct EpiResid {
    static constexpr bool PERM = false, AFTER_DRAIN = false;
    const float* base; float* out; const float* gate; int gpitch; float mul;
    __device__ __forceinline__ void operator()(const f32x4 (&acc)[2][2][4][2], const Unit& u, int wr, int wc, int fr, int fq) const {
        const int b = (u.pm * BM) >> 11;
        const int col0 = u.pn * BM + wc * 32 + 4 * fq;
        f32x4 gv[2][2];
#pragma unroll
        for (int bj = 0; bj < 2; ++bj)
#pragma unroll
            for (int n = 0; n < 2; ++n) gv[bj][n] = *(const f32x4*)(gate + (size_t)b * gpitch + col0 + bj * HALF + n * 16) * mul;
#pragma unroll
        for (int ai = 0; ai < 2; ++ai)
#pragma unroll
            for (int m = 0; m < 4; ++m) { const size_t off = (size_t)(u.pm * BM + ai * HALF + wr * 64 + m * 16 + fr) * 1024 + col0;
#pragma unroll
                for (int bj = 0; bj < 2; ++bj)
#pragma unroll
                    for (int n = 0; n < 2; ++n) { const f32x4 bs = *(const f32x4*)(base + off + bj * HALF + n * 16);
                        *(f32x4*)(out + off + bj * HALF + n * 16) = bs + gv[bj][n] * acc[ai][bj][m][n]; } }
    }
};
template <class Epi, class Sched, bool ALIGN_EPI = false, bool SP2 = false>
__device__ __forceinline__ void gemm_phase(PG8_LAS unsigned char* lds, const Gemm g, const Sched& S, const Epi& E) {
    const int tid = tid_l(), wid = __builtin_amdgcn_readfirstlane(tid >> 6), lane = tid & 63, wr = wid >> 2, wc = wid & 3, fr = lane & 15, fq = lane >> 4;
    const int K = g.K, nt = K / BK;
    unsigned voffA[2], voffB[2];
#pragma unroll
    for (int i = 0; i < 2; ++i) { int R, C; stage_rc(tid * 16 + i * 8192, R, C); const int Rb = Epi::PERM ? ((R & ~31) + perm32(R & 31)) : R;
        voffA[i] = (unsigned)(R * K + C) * 2u; voffB[i] = (unsigned)(Rb * K + C) * 2u; }
    const size_t kstep = (size_t)(BK * 2);
    const size_t hstep = (size_t)HALF * K * 2;
    const size_t tstep = 2 * hstep;
    const unsigned ldsw = (unsigned)wid * 1024u;
    const int aoff = lds_byte(wr * 64 + fr, fq * 8), boff = lds_byte(wc * 32 + fr, fq * 8);
#define PG8_SA(b, h) (((b) * 2 + (h)) * HTB)
#define PG8_SB(b, h) ((4 + (b) * 2 + (h)) * HTB)
#define PG8_STAGE(bufoff, gbase, voff) do { _Pragma("unroll") for (int _i = 0; _i < 2; ++_i) \
        __builtin_amdgcn_global_load_lds((const unsigned*)((const char*)(gbase) + (voff)[_i]), (PG8_LAS unsigned*)(lds + (bufoff) + ldsw + _i * 8192), 16, 0, 0); } while (0)
#define PG8_LDA(dst, b, h) do { _Pragma("unroll") for (int m = 0; m < 4; ++m) _Pragma("unroll") for (int k = 0; k < 2; ++k) dst[m][k] = *(const PG8_LAS bf16x8*)(lds + PG8_SA(b, h) + aoff + m * 2048 + k * 1024); } while (0)
#define PG8_LDB(dst, b, h) do { _Pragma("unroll") for (int n = 0; n < 2; ++n) _Pragma("unroll") for (int k = 0; k < 2; ++k) dst[n][k] = *(const PG8_LAS bf16x8*)(lds + PG8_SB(b, h) + boff + n * 2048 + k * 1024); } while (0)
#define PG8_MMA(ai, bj, At, Bt) do { __builtin_amdgcn_s_setprio(1); _Pragma("unroll") for (int m = 0; m < 4; ++m) _Pragma("unroll") for (int n = 0; n < 2; ++n) _Pragma("unroll") for (int k = 0; k < 2; ++k) \
        acc[ai][bj][m][n] = __builtin_amdgcn_mfma_f32_16x16x32_bf16(Bt[n][k], At[m][k], acc[ai][bj][m][n], 0, 0, 0); __builtin_amdgcn_s_setprio(0); } while (0)
#define PG8_WAIT_V(n) asm volatile("s_waitcnt vmcnt(" #n ")" ::: "memory")
#define PG8_WAIT_L(n) asm volatile("s_waitcnt lgkmcnt(" #n ")" ::: "memory")
#define PG8_BAR __builtin_amdgcn_s_barrier()
#define PG8_SCHED __builtin_amdgcn_sched_barrier(0)
    Unit cur, nxt; int ui = 0;
    if (!S.next(0, cur)) return;
    f32x4 acc[2][2][4][2];
#pragma unroll
    for (int a = 0; a < 2; ++a)
#pragma unroll
        for (int b = 0; b < 2; ++b)
#pragma unroll
            for (int m = 0; m < 4; ++m)
#pragma unroll
                for (int n = 0; n < 2; ++n) acc[a][b][m][n] = (f32x4){0.f, 0.f, 0.f, 0.f};
    bf16x8 At[4][2], B0[2][2], B1[2][2];
    const char* cA = (const char*)g.A + (size_t)cur.pm * tstep; const char* cB = (const char*)g.Bt + (size_t)cur.pn * tstep;
    S.a_ready(cur);
    if constexpr (SP2) {
        PG8_STAGE(PG8_SB(0, 0), cB, voffB); PG8_STAGE(PG8_SB(0, 1), cB + hstep, voffB); PG8_STAGE(PG8_SA(0, 0), cA, voffA); PG8_STAGE(PG8_SA(0, 1), cA + hstep, voffA);
        if (wr == 1) PG8_BAR;
        PG8_WAIT_V(2); PG8_BAR;
        PG8_STAGE(PG8_SB(1, 0), cB + kstep, voffB); PG8_STAGE(PG8_SA(1, 0), cA + kstep, voffA); PG8_STAGE(PG8_SB(1, 1), cB + hstep + kstep, voffB);
        PG8_WAIT_V(6); PG8_BAR;
    } else {
        PG8_STAGE(PG8_SB(0, 0), cB, voffB); PG8_STAGE(PG8_SA(0, 0), cA, voffA); PG8_STAGE(PG8_SB(0, 1), cB + hstep, voffB); PG8_STAGE(PG8_SA(0, 1), cA + hstep, voffA);
        if (wr == 1) PG8_BAR;
        PG8_WAIT_V(4); PG8_BAR;
        PG8_STAGE(PG8_SB(1, 0), cB + kstep, voffB); PG8_STAGE(PG8_SA(1, 0), cA + kstep, voffA); PG8_STAGE(PG8_SB(1, 1), cB + hstep + kstep, voffB);
        PG8_WAIT_V(6); PG8_BAR;
    }
    for (;;) {
        const bool has_next = S.next(ui + 1, nxt);
        const char* nA = has_next ? (const char*)g.A + (size_t)nxt.pm * tstep : cA; const char* nB = has_next ? (const char*)g.Bt + (size_t)nxt.pn * tstep : cB;
        for (int t = 0; t < nt; t += 2) {
            const bool last = (t == nt - 2);
            const char* a1 = cA + (size_t)(t + 1) * kstep;
            const char* a2 = last ? nA : cA + (size_t)(t + 2) * kstep; const char* b2 = last ? nB : cB + (size_t)(t + 2) * kstep;
            const char* a3 = a2 + kstep; const char* b3 = b2 + kstep;
            if (last && has_next) S.a_ready(nxt);
            if constexpr (SP2) {
            PG8_LDB(B0, 0, 0); PG8_LDB(B1, 0, 1); PG8_SCHED; PG8_LDA(At, 0, 0); PG8_STAGE(PG8_SA(1, 1), a1 + hstep, voffA);
            PG8_WAIT_V(8); PG8_WAIT_L(0); PG8_BAR; PG8_MMA(0, 0, At, B0); PG8_MMA(0, 1, At, B1); PG8_BAR; PG8_SCHED;
            PG8_LDA(At, 0, 1); PG8_STAGE(PG8_SB(0, 0), b2, voffB); PG8_STAGE(PG8_SB(0, 1), b2 + hstep, voffB); PG8_STAGE(PG8_SA(0, 0), a2, voffA);
            PG8_WAIT_V(8); PG8_WAIT_L(0); PG8_BAR; PG8_MMA(1, 0, At, B0); PG8_MMA(1, 1, At, B1); PG8_BAR; PG8_SCHED;
            PG8_LDB(B0, 1, 0); PG8_LDB(B1, 1, 1); PG8_SCHED; PG8_LDA(At, 1, 0); PG8_STAGE(PG8_SA(0, 1), a2 + hstep, voffA);
            PG8_WAIT_V(8); PG8_WAIT_L(0); PG8_BAR; PG8_MMA(0, 0, At, B0); PG8_MMA(0, 1, At, B1); PG8_BAR; PG8_SCHED;
            PG8_LDA(At, 1, 1); PG8_STAGE(PG8_SB(1, 0), b3, voffB); PG8_STAGE(PG8_SB(1, 1), b3 + hstep, voffB); PG8_STAGE(PG8_SA(1, 0), a3, voffA);
            PG8_WAIT_V(8); PG8_WAIT_L(0); PG8_BAR; PG8_MMA(1, 0, At, B0); PG8_MMA(1, 1, At, B1); PG8_BAR; PG8_SCHED;
            } else {
            PG8_LDB(B0, 0, 0); PG8_SCHED; PG8_LDA(At, 0, 0); PG8_STAGE(PG8_SA(1, 1), a1 + hstep, voffA);
            PG8_WAIT_L(8); PG8_BAR; PG8_WAIT_L(0); PG8_MMA(0, 0, At, B0); PG8_BAR; PG8_SCHED;
            PG8_LDB(B1, 0, 1); PG8_STAGE(PG8_SB(0, 0), b2, voffB);
            PG8_BAR; PG8_WAIT_L(0); PG8_MMA(0, 1, At, B1); PG8_BAR;
            PG8_LDA(At, 0, 1); PG8_STAGE(PG8_SA(0, 0), a2, voffA);
            PG8_BAR; PG8_WAIT_L(0); PG8_MMA(1, 0, At, B0); PG8_BAR; PG8_SCHED;
            PG8_STAGE(PG8_SB(0, 1), b2 + hstep, voffB);
            PG8_WAIT_V(6); PG8_BAR; PG8_MMA(1, 1, At, B1); PG8_BAR;
            PG8_LDB(B0, 1, 0); PG8_SCHED; PG8_LDA(At, 1, 0); PG8_STAGE(PG8_SA(0, 1), a2 + hstep, voffA);
            PG8_WAIT_L(8); PG8_BAR; PG8_WAIT_L(0); PG8_MMA(0, 0, At, B0); PG8_BAR; PG8_SCHED;
            PG8_LDB(B1, 1, 1); PG8_STAGE(PG8_SB(1, 0), b3, voffB);
            PG8_BAR; PG8_WAIT_L(0); PG8_MMA(0, 1, At, B1); PG8_BAR;
            PG8_LDA(At, 1, 1); PG8_STAGE(PG8_SA(1, 0), a3, voffA);
            PG8_BAR; PG8_WAIT_L(0); PG8_MMA(1, 0, At, B0); PG8_BAR; PG8_SCHED;
            PG8_STAGE(PG8_SB(1, 1), b3 + hstep, voffB);
            PG8_WAIT_V(6); PG8_BAR; PG8_MMA(1, 1, At, B1); PG8_BAR;
            }
        }
        if constexpr (ALIGN_EPI) { if (wr == 0) PG8_BAR; }
        if constexpr (!Epi::AFTER_DRAIN) { E(acc, cur, wr, wc, fr, fq); S.done(cur); }
        if (!has_next) break;
#pragma unroll
        for (int a = 0; a < 2; ++a)
#pragma unroll
            for (int b = 0; b < 2; ++b)
#pragma unroll
                for (int m = 0; m < 4; ++m)
#pragma unroll
                    for (int n = 0; n < 2; ++n) acc[a][b][m][n] = (f32x4){0.f, 0.f, 0.f, 0.f};
        cur = nxt; cA = nA; cB = nB; ++ui;
        if constexpr (ALIGN_EPI) { if (wr == 1) PG8_BAR; }
    }
    PG8_WAIT_V(0);
    if constexpr (!ALIGN_EPI) { if (wr == 0) PG8_BAR; }
    PG8_BAR;
    if constexpr (Epi::AFTER_DRAIN) { E.fused(acc, cur, wr, wc, fr, fq, lds, wid, lane); S.done(cur); }
#undef PG8_SA
#undef PG8_SB
#undef PG8_STAGE
#undef PG8_LDA
#undef PG8_LDB
#undef PG8_MMA
#undef PG8_WAIT_V
#undef PG8_WAIT_L
#undef PG8_BAR
#undef PG8_SCHED
}
}
#define LAS __attribute__((address_space(3)))
typedef unsigned short bf16;
typedef float f32x4 __attribute__((ext_vector_type(4)));
typedef float f32x2 __attribute__((ext_vector_type(2)));
typedef unsigned u32x4 __attribute__((ext_vector_type(4)));
typedef unsigned u32x2 __attribute__((ext_vector_type(2)));

constexpr int D = 1024, BATCH = 8, SEQ = 2048, M = BATCH * SEQ, DFF = 2816, NMODC = 9 * 1024, DIN = 3848, NPROJ = 3840;
constexpr int NWAVES = 8, NTHR = 512;
constexpr float EPS = 1e-6f;
constexpr int PC_SBQ = 0, PC_SBK = 256, PC_SBV = 512, PC_GQ = 768, PC_GZ = 2304, PC_HQ = 2816, PC_HF = 3072, PC_HI = 3328, PC_HG = 3584;
constexpr size_t MiB = 1u << 20;
constexpr size_t WS_MOD = 0, MOD_BYTES = (size_t)2 * 8 * NMODC * 4, WS_BAR = 768 * 1024, WS_TASK = 800 * 1024, ZERO_BYTES = 1 * MiB;
constexpr size_t WS_BA = 1 * MiB, WS_GS = 2 * MiB, WS_W1IN = 3 * MiB, WS_W1OUT = 14 * MiB, WS_WMI = 20 * MiB, WS_WMO = 28 * MiB, WS_W2IN = 30 * MiB, WS_W2OUT = 41 * MiB;
constexpr size_t WS_H = 47 * MiB, WS_PROJ = 79 * MiB, WS_QD = 199 * MiB, WS_W = 215 * MiB, WS_U = 231 * MiB, WS_OMIX = 247 * MiB, WS_KDT = 263 * MiB, WS_AQK = 279 * MiB, WS_VT = 287 * MiB, WS_CD = 295 * MiB, WS_P3 = 296 * MiB, WS_END = 304 * MiB;
constexpr int LDS_BYTES = 147456;

struct Params { const float* in[21]; float* out; unsigned char* ws; };

__device__ __forceinline__ float bflo(unsigned u) { return __uint_as_float(u << 16); }
__device__ __forceinline__ float bfhi(unsigned u) { return __uint_as_float(u & 0xffff0000u); }
typedef __bf16 bf16x2v_t __attribute__((ext_vector_type(2)));
__device__ __forceinline__ unsigned pk2(float lo, float hi) { const f32x2 v = {lo, hi}; return __builtin_bit_cast(unsigned, __builtin_convertvector(v, bf16x2v_t)); }
__device__ __forceinline__ unsigned f2bf(float f) { return pk2(f, 0.f) & 0xffffu; }
__device__ __forceinline__ float wave_sum(float v) {
#pragma unroll
    for (int o = 1; o < 64; o <<= 1) v += __shfl_xor(v, o);
    return v;
}
template <int CTRL> __device__ __forceinline__ float dpp_mov(float x) { return __int_as_float(__builtin_amdgcn_update_dpp(0, __float_as_int(x), CTRL, 0xF, 0xF, false)); }
__device__ __forceinline__ float rlane(float x, int l) { return __uint_as_float(__builtin_amdgcn_readlane(__float_as_uint(x), l)); }
__device__ __forceinline__ float wave_sum_fast(float x) {
    x += dpp_mov<0xB1>(x); x += dpp_mov<0x4E>(x); x += dpp_mov<0x141>(x); x += dpp_mov<0x140>(x);
    return (rlane(x, 0) + rlane(x, 16)) + (rlane(x, 32) + rlane(x, 48));
}
__device__ __forceinline__ float silu(float g) { return g * __builtin_amdgcn_rcpf(1.0f + __expf(-g)); }
__device__ __forceinline__ float softplus_precise(float x) { return fmaxf(x, 0.f) + log1pf(expf(-fabsf(x))); }

__device__ __forceinline__ void phase_ada(const Params& p, LAS unsigned char* lds) {
    LAS float* sc = (LAS float*)lds;
    const float* c = p.in[1];
    for (int i = tid_l(); i < 8 * 1024; i += NTHR) { const float v = c[i]; sc[i] = v / (1.0f + expf(-v)); }
    __syncthreads();
    float* MOD = (float*)(p.ws + WS_MOD);
    for (int item = blockIdx.x; item < 288; item += gridDim.x) {
        const int l = item / 144, r = item % 144, cgp = r >> 3, ks = r & 7;
        const int n = cgp * 512 + tid_l();
        const float* W = p.in[18] + (size_t)l * 1024 * NMODC + n;
        float acc[8];
#pragma unroll
        for (int b = 0; b < 8; ++b) acc[b] = 0.f;
        for (int k = ks * 128; k < ks * 128 + 128; ++k) { const float w = W[(size_t)k * NMODC];
#pragma unroll
            for (int b = 0; b < 8; ++b) acc[b] += sc[b * 1024 + k] * w; }
        const float bias = (ks == 0) ? p.in[19][l * NMODC + n] : 0.f;
#pragma unroll
        for (int b = 0; b < 8; ++b) atomicAdd(&MOD[(size_t)(l * 8 + b) * NMODC + n], acc[b] + bias);
    }
    __syncthreads();
}

__device__ __forceinline__ void transpose_item(const float* W, int Nsrc, int K, int k0, int nsrc0, bf16* WT, int drow0, LAS float* scr, int lane) {
#pragma unroll 8
    for (int i = 0; i < 32; ++i) { const int kk = 2 * i + (lane >> 5); scr[kk * 33 + (lane & 31)] = W[(size_t)(k0 + kk) * Nsrc + nsrc0 + (lane & 31)]; }
    asm volatile("s_waitcnt lgkmcnt(0)" ::: "memory");
    const int c = lane & 7;
#pragma unroll
    for (int j = 0; j < 4; ++j) { const int n = (lane >> 3) + 8 * j; const LAS float* s = scr + (8 * c) * 33 + n;
        u32x4 o; o.x = pk2(s[0 * 33], s[1 * 33]); o.y = pk2(s[2 * 33], s[3 * 33]); o.z = pk2(s[4 * 33], s[5 * 33]); o.w = pk2(s[6 * 33], s[7 * 33]);
        *(u32x4*)(WT + (size_t)(drow0 + n) * K + k0 + 8 * c) = o; }
    asm volatile("s_waitcnt lgkmcnt(0)" ::: "memory");
}
__device__ __forceinline__ void phase_convert(const Params& p, int l, LAS unsigned char* lds) {
    const int tid_ = tid_l(); const int wave = __builtin_amdgcn_readfirstlane(tid_ >> 6), lane = tid_ & 63;
    LAS float* scr = (LAS float*)(lds + wave * 16384);
    const int gw = blockIdx.x * NWAVES + wave, NGW = gridDim.x * NWAVES;
    unsigned char* ws = p.ws;
    constexpr int I_IN = 16 * 176, I_OUT = 44 * 32, I_MI = 16 * 120, I_MO = 16 * 32;
    constexpr int NITEMS = 2 * (I_IN + I_OUT) + I_MI + I_MO;
    for (int it = gw; it < NITEMS; it += NGW) {
        int r = it;
        if (r < I_IN || (r >= I_IN + I_OUT + I_MI + I_MO && r < 2 * I_IN + I_OUT + I_MI + I_MO)) {
            const bool second = r >= I_IN; if (second) r -= I_IN + I_OUT + I_MI + I_MO;
            const float* W = (second ? p.in[16] : p.in[3]) + (size_t)l * 1024 * 2 * DFF;
            bf16* WT = (bf16*)(ws + (second ? WS_W2IN : WS_W1IN));
            const int kb = r / 176, nb = r % 176, dn0 = nb * 32, pn = dn0 >> 8, bj = (dn0 >> 7) & 1, j = dn0 & 127;
            transpose_item(W, 2 * DFF, 1024, kb * 64, bj * DFF + pn * 128 + j, WT, dn0, scr, lane);
            continue;
        }
        r -= I_IN;
        if (r < I_OUT) { const float* W = p.in[4] + (size_t)l * DFF * 1024; transpose_item(W, 1024, DFF, (r / 32) * 64, (r % 32) * 32, (bf16*)(ws + WS_W1OUT), (r % 32) * 32, scr, lane); continue; }
        r -= I_OUT;
        if (r < I_MI) { const float* W = p.in[6] + (size_t)l * 1024 * DIN; const int dn0 = (r % 120) * 32; transpose_item(W, DIN, 1024, (r / 120) * 64, dn0 < 2816 ? dn0 : dn0 + 8, (bf16*)(ws + WS_WMI), dn0, scr, lane); continue; }
        r -= I_MI;
        if (r < I_MO) { const float* W = p.in[14] + (size_t)l * 1024 * 1024; transpose_item(W, 1024, 1024, (r / 32) * 64, (r % 32) * 32, (bf16*)(ws + WS_WMO), (r % 32) * 32, scr, lane); continue; }
        r -= I_MO; r -= I_IN;
        { const float* W = p.in[17] + (size_t)l * DFF * 1024; transpose_item(W, 1024, DFF, (r / 32) * 64, (r % 32) * 32, (bf16*)(ws + WS_W2OUT), (r % 32) * 32, scr, lane); }
    }
}

template <bool WITH_BA>
__device__ __forceinline__ void phase_norm(const float* X, const float* gain, const float* shiftp, const float* scalep, bf16* H,
                                           const float* wmi, float* BAout, LAS unsigned char* lds) {
    const int tid_ = tid_l(); const int wave = __builtin_amdgcn_readfirstlane(tid_ >> 6), lane = tid_ & 63;
    LAS float* wba = (LAS float*)lds;
    if (WITH_BA) {
        for (int i = tid_; i < 1024 * 8; i += NTHR) wba[i] = wmi[(size_t)(i >> 3) * DIN + 2816 + (i & 7)];
        __syncthreads();
    }
    const int gw = blockIdx.x * NWAVES + wave, NGW = gridDim.x * NWAVES;
    for (int rg = gw; rg < M / 8; rg += NGW) {
        const int b = (rg * 8) >> 11;
        f32x4 gp[4], sh[4];
#pragma unroll
        for (int j = 0; j < 4; ++j) { const int col = 256 * j + 4 * lane;
            const f32x4 g = *(const f32x4*)(gain + col), s = *(const f32x4*)(scalep + (size_t)b * NMODC + col);
            gp[j] = g * (1.0f + s); sh[j] = *(const f32x4*)(shiftp + (size_t)b * NMODC + col); }
        for (int i = 0; i < 8; ++i) {
            const int m = rg * 8 + i;
            f32x4 v[4]; float ss = 0.f;
#pragma unroll
            for (int j = 0; j < 4; ++j) { v[j] = *(const f32x4*)(X + (size_t)m * D + 256 * j + 4 * lane); ss += (v[j].x * v[j].x + v[j].y * v[j].y) + (v[j].z * v[j].z + v[j].w * v[j].w); }
            const float rstd = __builtin_amdgcn_rsqf(wave_sum_fast(ss) * (1.0f / D) + EPS);
#pragma unroll
            for (int j = 0; j < 4; ++j) { v[j] = v[j] * rstd * gp[j] + sh[j];
                u32x2 o; o.x = pk2(v[j].x, v[j].y); o.y = pk2(v[j].z, v[j].w);
                *(u32x2*)(H + (size_t)m * D + 256 * j + 4 * lane) = o; }
            if (WITH_BA) {
                float acc[8];
#pragma unroll
                for (int q = 0; q < 8; ++q) acc[q] = 0.f;
#pragma unroll
                for (int j = 0; j < 4; ++j)
#pragma unroll
                    for (int e = 0; e < 4; ++e) { const int k = 256 * j + 4 * lane + e; const f32x4 w0 = *(const LAS f32x4*)(wba + k * 8), w1 = *(const LAS f32x4*)(wba + k * 8 + 4); const float hv = v[j][e];
                        acc[0] += hv * w0.x; acc[1] += hv * w0.y; acc[2] += hv * w0.z; acc[3] += hv * w0.w; acc[4] += hv * w1.x; acc[5] += hv * w1.y; acc[6] += hv * w1.z; acc[7] += hv * w1.w; }
#pragma unroll
                for (int q = 0; q < 8; ++q) acc[q] = wave_sum(acc[q]);
                if (lane == 0) { *(f32x4*)(BAout + (size_t)m * 8) = (f32x4){acc[0], acc[1], acc[2], acc[3]}; *(f32x4*)(BAout + (size_t)m * 8 + 4) = (f32x4){acc[4], acc[5], acc[6], acc[7]}; }
            }
        }
    }
    if (WITH_BA) __syncthreads();
}

__device__ __forceinline__ void phase_final(float* X, const float* gain) {
    const int tid_ = tid_l(); const int wave = __builtin_amdgcn_readfirstlane(tid_ >> 6), lane = tid_ & 63;
    const int gw = blockIdx.x * NWAVES + wave, NGW = gridDim.x * NWAVES;
    f32x4 g[4];
#pragma unroll
    for (int j = 0; j < 4; ++j) g[j] = *(const f32x4*)(gain + 256 * j + 4 * lane);
    for (int m = gw; m < M; m += NGW) {
        f32x4 v[4]; float ss = 0.f;
#pragma unroll
        for (int j = 0; j < 4; ++j) { v[j] = *(const f32x4*)(X + (size_t)m * D + 256 * j + 4 * lane); ss += (v[j].x * v[j].x + v[j].y * v[j].y) + (v[j].z * v[j].z + v[j].w * v[j].w); }
        const float rstd = __builtin_amdgcn_rsqf(wave_sum_fast(ss) * (1.0f / D) + EPS);
#pragma unroll
        for (int j = 0; j < 4; ++j) *(f32x4*)(X + (size_t)m * D + 256 * j + 4 * lane) = v[j] * rstd * g[j];
    }
}

#define LDS_BARRIER() do { asm volatile("s_waitcnt lgkmcnt(0)" ::: "memory"); __builtin_amdgcn_s_barrier(); asm volatile("" ::: "memory"); } while (0)
typedef short bf16x8_t __attribute__((ext_vector_type(8)));
__device__ __forceinline__ void phase_prep(const Params& p, int l, LAS unsigned char* lds) {
    const int tid_ = tid_l(); const int wave = __builtin_amdgcn_readfirstlane(tid_ >> 6), lane = tid_ & 63;
    const int gw = blockIdx.x * NWAVES + wave, NGW = gridDim.x * NWAVES;
    const bf16* PROJ = (const bf16*)(p.ws + WS_PROJ); const float* BA = (const float*)(p.ws + WS_BA);
    {
        LAS bf16* tile = (LAS bf16*)(lds + wave * 16384); bf16* VT = (bf16*)(p.ws + WS_VT);
        for (int item = gw; item < 1024; item += NGW) {
            const int bh = item >> 5, tb = item & 31, b = bh >> 2, h = bh & 3; const size_t mt = (size_t)b * SEQ + tb * 64;
#pragma unroll
            for (int r0 = 0; r0 < 64; r0 += 16) { unsigned tv[16];
#pragma unroll
                for (int r = 0; r < 16; ++r) tv[r] = PROJ[(mt + r0 + r) * NPROJ + PC_SBV + h * 64 + lane];
#pragma unroll
                for (int r = 0; r < 16; ++r) tile[(r0 + r) * 66 + lane] = (bf16)tv[r]; }
            asm volatile("s_waitcnt lgkmcnt(0)" ::: "memory");
#pragma unroll 16
            for (int d = 0; d < 64; ++d) VT[((size_t)bh * 64 + d) * SEQ + tb * 64 + lane] = tile[lane * 66 + d];
            asm volatile("s_waitcnt lgkmcnt(0)" ::: "memory");
        }
        __syncthreads();
    }
    bf16* QD = (bf16*)(p.ws + WS_QD); bf16* Wg = (bf16*)(p.ws + WS_W); bf16* Ug = (bf16*)(p.ws + WS_U);
    bf16* KDT = (bf16*)(p.ws + WS_KDT); bf16* AQK = (bf16*)(p.ws + WS_AQK); float* CD = (float*)(p.ws + WS_CD);
    const float* cw = p.in[7] + (size_t)l * 4 * 1536; const float* A_log = p.in[8] + l * 4; const float* dtb = p.in[9] + l * 4;
    LAS bf16* Kb = (LAS bf16*)lds; LAS bf16* Qb = Kb + 64 * 136; LAS bf16* Vb = Qb + 64 * 136;
    LAS float* Akk = (LAS float*)(lds + 3 * 17408);
    LAS float* s_la = Akk + 64 * 68; LAS float* s_beta = s_la + 64; LAS float* s_g = s_beta + 64; LAS float* s_eg = s_g + 64;
    const int g = lane >> 4, c = lane & 15;
    for (int unit = blockIdx.x; unit < 1024; unit += gridDim.x) {
        const int bh = unit >> 5, n = unit & 31, b = bh >> 2, h = bh & 3; const size_t m0 = (size_t)b * SEQ + n * 64;
        const int cq = h * 128 + 2 * lane;
        f32x2 cwq[4], cwk[4], cwv[4];
#pragma unroll
        for (int j = 0; j < 4; ++j) { cwq[j] = *(const f32x2*)(cw + j * 1536 + cq); cwk[j] = *(const f32x2*)(cw + j * 1536 + 512 + cq); cwv[j] = *(const f32x2*)(cw + j * 1536 + 1024 + cq); }
        unsigned xq[11], xk[11], xv[11];
#pragma unroll
        for (int rr = 0; rr < 11; ++rr) { const int r_ = wave * 8 - 3 + rr;
            if (n * 64 + r_ >= 0) { const bf16* row = PROJ + (size_t)((long)m0 + r_) * NPROJ + PC_GQ + cq; xq[rr] = *(const unsigned*)row; xk[rr] = *(const unsigned*)(row + 512); xv[rr] = *(const unsigned*)(row + 1024); }
            else { xq[rr] = 0u; xk[rr] = 0u; xv[rr] = 0u; } }
#pragma unroll
        for (int i = 0; i < 8; ++i) {
            const int r = wave * 8 + i; const size_t m = m0 + r;
            float q0 = 0.f, q1 = 0.f, k0 = 0.f, k1 = 0.f, v0 = 0.f, v1 = 0.f;
#pragma unroll
            for (int j = 0; j < 4; ++j) { const unsigned uq = xq[i + j], uk = xk[i + j], uv = xv[i + j];
                q0 += cwq[j].x * bflo(uq); q1 += cwq[j].y * bfhi(uq); k0 += cwk[j].x * bflo(uk); k1 += cwk[j].y * bfhi(uk); v0 += cwv[j].x * bflo(uv); v1 += cwv[j].y * bfhi(uv); }
            q0 = silu(q0); q1 = silu(q1); k0 = silu(k0); k1 = silu(k1); v0 = silu(v0); v1 = silu(v1);
            const float sq = wave_sum_fast(q0 * q0 + q1 * q1), sk = wave_sum_fast(k0 * k0 + k1 * k1);
            const float rq = (__builtin_amdgcn_rsqf(sq + EPS)) * 0.08838834764831845f, rk = __builtin_amdgcn_rsqf(sk + EPS);
            *(LAS unsigned*)(Qb + r * 136 + 2 * lane) = pk2(q0 * rq, q1 * rq); *(LAS unsigned*)(Kb + r * 136 + 2 * lane) = pk2(k0 * rk, k1 * rk); *(LAS unsigned*)(Vb + r * 136 + 2 * lane) = pk2(v0, v1);
            if (lane == 0) {
                s_beta[r] = 1.0f / (1.0f + expf(-BA[m * 8 + h]));
                s_la[r] = -expf(A_log[h]) * softplus_precise(BA[m * 8 + 4 + h] + dtb[h]);
            }
        }
        LDS_BARRIER();
        if (wave == 0) { float x = s_la[lane];
#pragma unroll
            for (int o = 1; o < 64; o <<= 1) { const float tmp = __shfl_up(x, o); if (lane >= o) x += tmp; }
            s_g[lane] = x; s_eg[lane] = expf(x); }
        LDS_BARRIER();
        for (int q = 0; q < 4; ++q) {
            const int idx = wave * 4 + q; const bool isQK = idx >= 16; const int ti = (idx >> 2) & 3, tj = idx & 3;
            f32x4 acc = (f32x4){0.f, 0.f, 0.f, 0.f};
            if (tj <= ti) {
                const LAS bf16* X = isQK ? Qb : Kb;
#pragma unroll
                for (int ks = 0; ks < 4; ++ks) { const bf16x8_t a = *(const LAS bf16x8_t*)(X + (16 * ti + c) * 136 + 32 * ks + 8 * g), bb = *(const LAS bf16x8_t*)(Kb + (16 * tj + c) * 136 + 32 * ks + 8 * g);
                    acc = __builtin_amdgcn_mfma_f32_16x16x32_bf16(a, bb, acc, 0, 0, 0); }
            }
#pragma unroll
            for (int i = 0; i < 4; ++i) { const int row = 16 * ti + 4 * g + i, col = 16 * tj + c;
                const float dec = (col <= row) ? __expf(s_g[row] - s_g[col]) : 0.f;
                if (isQK) AQK[((size_t)unit * 64 + row) * 64 + col] = (bf16)f2bf(dec * acc[i]);
                else Akk[col * 68 + row] = (col < row) ? s_beta[row] * dec * acc[i] : 0.f; }
        }
        LDS_BARRIER();
        if (wave < 4) {
            const bool isW = wave >= 2; const int col = tid_ & 127;
            const LAS bf16* src = isW ? Kb : Vb; bf16* dst = (isW ? Wg : Ug) + m0 * 512 + h * 128 + col;
            float X[64];
            int lz; asm volatile("v_mov_b32 %0, 0" : "=v"(lz));
            const LAS float* Ak = Akk + lz; const LAS float* sb_ = s_beta + lz; const LAS float* se_ = s_eg + lz;
#pragma unroll
            for (int i = 0; i < 64; ++i) { X[i] = sb_[i] * (isW ? se_[i] : 1.0f) * __uint_as_float((unsigned)src[i * 136 + col] << 16);
                if ((i & 7) == 7) asm volatile("" : "+v"(X[i - 7]), "+v"(X[i - 6]), "+v"(X[i - 5]), "+v"(X[i - 4]), "+v"(X[i - 3]), "+v"(X[i - 2]), "+v"(X[i - 1]), "+v"(X[i]) :: "memory"); }
#pragma unroll
            for (int j = 0; j < 63; ++j) {
                f32x4 arow[16];
#pragma unroll
                for (int i4 = (j >> 2) << 2; i4 < 64; i4 += 4) arow[i4 >> 2] = *(const LAS f32x4*)(Ak + j * 68 + i4);
                const float xj = X[j];
                *dst = (bf16)f2bf(xj); dst += 512; asm volatile("" : "+v"(dst));
                asm volatile("s_waitcnt lgkmcnt(0)" ::: "memory");
#pragma unroll
                for (int i4 = (j >> 2) << 2; i4 < 64; i4 += 4) { const f32x4 a = arow[i4 >> 2];
                    X[i4] -= a.x * xj; X[i4 + 1] -= a.y * xj; X[i4 + 2] -= a.z * xj; X[i4 + 3] -= a.w * xj; }
            }
            *dst = (bf16)f2bf(X[63]);
        } else {
            const int t2 = tid_ - 256;
            for (int idx = t2; idx < 64 * 64; idx += 256) { const int r = idx >> 6, dp = idx & 63; const unsigned u = *(const LAS unsigned*)(Qb + r * 136 + 2 * dp); const float e = s_eg[r];
                *(unsigned*)(QD + (m0 + r) * 512 + h * 128 + 2 * dp) = pk2(bflo(u) * e, bfhi(u) * e); }
            const int cc = t2 & 63; const float kd = __expf(s_g[63] - s_g[cc]);
            for (int d = t2 >> 6; d < 128; d += 4) KDT[((size_t)unit * 128 + d) * 64 + cc] = (bf16)f2bf(__uint_as_float((unsigned)Kb[cc * 136 + d] << 16) * kd);
            if (t2 == 0) CD[unit] = s_eg[63];
        }
        LDS_BARRIER();
    }
}

template <bool DUMMY>
__device__ __forceinline__ void gdn_scan_block(const Params& p, int l, int unit, LAS unsigned char* lds) {
    const int tid_ = tid_l(); const int w = __builtin_amdgcn_readfirstlane(tid_ >> 6), lane = tid_ & 63, g = lane >> 4, c = lane & 15;
    const int bh = unit >> 1, eh = unit & 1, b = bh >> 2, h = bh & 3, te = w & 3, rh = w >> 2;
    LAS bf16* ST = (LAS bf16*)lds; LAS bf16* Wb = ST + 64 * 136; LAS bf16* QDb = Wb + 64 * 136; LAS bf16* KDTb = QDb + 64 * 136;
    LAS bf16* AQb = KDTb + 128 * 72; LAS bf16* vnT = AQb + 64 * 72 + w * (16 * 72); LAS bf16* Ub = AQb + 64 * 72 + 8 * 16 * 72;
    const bf16* QD = (const bf16*)(p.ws + WS_QD); const bf16* Wg = (const bf16*)(p.ws + WS_W); const bf16* Ug = (const bf16*)(p.ws + WS_U);
    const bf16* KDT = (const bf16*)(p.ws + WS_KDT); const bf16* AQK = (const bf16*)(p.ws + WS_AQK); const float* CD = (const float*)(p.ws + WS_CD);
    bf16* Uraw = (bf16*)(p.ws + (DUMMY ? WS_KDT : WS_U));
    for (int i = tid_; i < 64 * 136 / 2; i += NTHR) ((LAS unsigned*)ST)[i] = 0u;
    f32x4 S[4];
#pragma unroll
    for (int j = 0; j < 4; ++j) S[j] = (f32x4){0.f, 0.f, 0.f, 0.f};
    u32x4 rW[2], rQ[2], rK[2], rA, rU; float cdn;
#define GDN_FETCH(n_) do { const size_t m0_ = (size_t)b * SEQ + (n_) * 64; const size_t unit_ = (size_t)bh * 32 + (n_); \
        _Pragma("unroll") for (int k_ = 0; k_ < 2; ++k_) { const int idx_ = tid_ + NTHR * k_; const size_t go_ = (m0_ + (idx_ >> 4)) * 512 + h * 128 + 8 * (idx_ & 15); \
            rW[k_] = *(const u32x4*)(Wg + go_); rQ[k_] = *(const u32x4*)(QD + go_); \
            rK[k_] = *(const u32x4*)(KDT + (unit_ * 128 + (idx_ >> 3)) * 64 + 8 * (idx_ & 7)); } \
        rU = *(const u32x4*)(Ug + (m0_ + (tid_ >> 3)) * 512 + h * 128 + 64 * eh + 8 * (tid_ & 7)); \
        rA = *(const u32x4*)(AQK + (unit_ * 64 + (tid_ >> 3)) * 64 + 8 * (tid_ & 7)); cdn = CD[unit_]; } while (0)
#define LDSFENCE() asm volatile("s_waitcnt lgkmcnt(0)" ::: "memory")
    GDN_FETCH(0);
    for (int n = 0; n < 32; ++n) {
        const size_t m0 = (size_t)b * SEQ + n * 64;
#pragma unroll
        for (int k = 0; k < 2; ++k) { const int idx = tid_ + NTHR * k; const int lo = (idx >> 4) * 136 + 8 * (idx & 15);
            *(LAS u32x4*)(Wb + lo) = rW[k]; *(LAS u32x4*)(QDb + lo) = rQ[k];
            *(LAS u32x4*)(KDTb + (idx >> 3) * 72 + 8 * (idx & 7)) = rK[k]; }
        *(LAS u32x4*)(Ub + (tid_ >> 3) * 72 + 8 * (tid_ & 7)) = rU;
        *(LAS u32x4*)(AQb + (tid_ >> 3) * 72 + 8 * (tid_ & 7)) = rA;
        const float cd = cdn;
        LDS_BARRIER();
        if (n + 1 < 32) GDN_FETCH(n + 1);
        bf16x8_t stf[4], af[4][4];
#pragma unroll
        for (int ks = 0; ks < 4; ++ks) stf[ks] = *(const LAS bf16x8_t*)(ST + (16 * te + c) * 136 + 32 * ks + 8 * g);
#pragma unroll
        for (int tc = 0; tc < 4; ++tc)
#pragma unroll
            for (int ks = 0; ks < 4; ++ks) af[tc][ks] = *(const LAS bf16x8_t*)(Wb + (16 * tc + c) * 136 + 32 * ks + 8 * g);
        float uv[4][4];
#pragma unroll
        for (int tc = 0; tc < 4; ++tc)
#pragma unroll
            for (int i = 0; i < 4; ++i) uv[tc][i] = __uint_as_float((unsigned)Ub[(16 * tc + 4 * g + i) * 72 + 16 * te + c] << 16);
        LDSFENCE();
#pragma unroll
        for (int tc = 0; tc < 4; ++tc) {
            f32x4 acc = (f32x4){0.f, 0.f, 0.f, 0.f};
#pragma unroll
            for (int ks = 0; ks < 4; ++ks) acc = __builtin_amdgcn_mfma_f32_16x16x32_bf16(af[tc][ks], stf[ks], acc, 0, 0, 0);
            u32x2 o; o.x = pk2(uv[tc][0] - acc[0], uv[tc][1] - acc[1]); o.y = pk2(uv[tc][2] - acc[2], uv[tc][3] - acc[3]);
            *(LAS u32x2*)(vnT + c * 72 + 16 * tc + 4 * g) = o;
        }
        bf16x8_t vf[2], qf[2][2];
#pragma unroll
        for (int t2 = 0; t2 < 2; ++t2)
#pragma unroll
            for (int ks = 0; ks < 4; ++ks) af[t2][ks] = *(const LAS bf16x8_t*)(QDb + (16 * (2 * rh + t2) + c) * 136 + 32 * ks + 8 * g);
#pragma unroll
        for (int t2 = 0; t2 < 2; ++t2)
#pragma unroll
            for (int ks = 0; ks < 2; ++ks) qf[t2][ks] = *(const LAS bf16x8_t*)(AQb + (16 * (2 * rh + t2) + c) * 72 + 32 * ks + 8 * g);
#pragma unroll
        for (int ks = 0; ks < 2; ++ks) vf[ks] = *(const LAS bf16x8_t*)(vnT + c * 72 + 32 * ks + 8 * g);
        LDSFENCE();
        f32x4 ot[2];
#pragma unroll
        for (int t2 = 0; t2 < 2; ++t2) {
            f32x4 acc = (f32x4){0.f, 0.f, 0.f, 0.f};
#pragma unroll
            for (int ks = 0; ks < 4; ++ks) acc = __builtin_amdgcn_mfma_f32_16x16x32_bf16(af[t2][ks], stf[ks], acc, 0, 0, 0);
#pragma unroll
            for (int ks = 0; ks < 2; ++ks) acc = __builtin_amdgcn_mfma_f32_16x16x32_bf16(qf[t2][ks], vf[ks], acc, 0, 0, 0);
            ot[t2] = acc;
        }
#pragma unroll
        for (int t2 = 0; t2 < 2; ++t2)
#pragma unroll
            for (int i = 0; i < 4; ++i) Uraw[(m0 + 16 * (2 * rh + t2) + 4 * g + i) * 512 + h * 128 + 64 * eh + 16 * te + c] = (bf16)f2bf(ot[t2][i]);
        bf16x8_t kf[4][2];
#pragma unroll
        for (int j = 0; j < 4; ++j)
#pragma unroll
            for (int ks = 0; ks < 2; ++ks) kf[j][ks] = *(const LAS bf16x8_t*)(KDTb + (16 * (4 * rh + j) + c) * 72 + 32 * ks + 8 * g);
        LDSFENCE();
#pragma unroll
        for (int j = 0; j < 4; ++j) {
            f32x4 acc = S[j] * cd;
#pragma unroll
            for (int ks = 0; ks < 2; ++ks) acc = __builtin_amdgcn_mfma_f32_16x16x32_bf16(kf[j][ks], vf[ks], acc, 0, 0, 0);
            S[j] = acc;
        }
        LDS_BARRIER();
#pragma unroll
        for (int j = 0; j < 4; ++j) { u32x2 o; o.x = pk2(S[j][0], S[j][1]); o.y = pk2(S[j][2], S[j][3]);
            *(LAS u32x2*)(ST + (16 * te + c) * 136 + 16 * (4 * rh + j) + 4 * g) = o; }
        LDS_BARRIER();
    }
#undef LDSFENCE
#undef GDN_FETCH
}

__device__ __forceinline__ void hgrn_scan_block(const Params& p, int l, int unit, LAS unsigned char* lds) {
    const int tid_ = tid_l(); const int w = __builtin_amdgcn_readfirstlane(tid_ >> 6), lane = tid_ & 63, tt = lane >> 2, dd = lane & 3;
    const int bh = unit >> 2, dq = unit & 3, b = bh >> 2, h = bh & 3; const size_t m0 = (size_t)b * SEQ;
    LAS float* coef = (LAS float*)lds + (w & 3) * (32 * 8);
    LAS float* part = (LAS float*)(lds + 8192);
    LAS bf16* vst = (LAS bf16*)(lds + 8192 + 65536);
    LAS bf16* qst = vst + 2 * 128 * 64;
    LAS bf16* fst = qst + 2 * 128 * 16;
    const bf16* PROJ = (const bf16*)(p.ws + WS_PROJ);
    bf16* OUT = dq == 0 ? (bf16*)(p.ws + WS_H) + m0 * D + 768 + h * 64 + lane
              : (dq == 3 ? (bf16*)(p.ws + WS_P3) : (bf16*)(p.ws + WS_OMIX) + (size_t)(dq - 1) * M * 256) + m0 * 256 + h * 64 + lane;
    const int opitch = dq ? 256 : D;
    const int dcol = h * 64 + 16 * dq + 4 * (w & 3) + dd;
    float lb = 0.f;
    if (l == 1) lb = 1.0f / (1.0f + expf(p.in[13][dcol] - p.in[13][256 + dcol]));
    f32x2 S2[2]; S2[0] = (f32x2){0.f, 0.f}; S2[1] = (f32x2){0.f, 0.f};
    u32x4 rv[2], rq;
    const bf16* gq = PROJ + m0 * NPROJ + (tid_ < 256 ? PC_HQ : PC_HF) + h * 64 + 16 * dq + 8 * (tid_ & 1);
#define HG_FETCH(sg_) do { const size_t t0_ = (size_t)(sg_) * 128; \
        _Pragma("unroll") for (int k_ = 0; k_ < 2; ++k_) { const int idx_ = tid_ + NTHR * k_; rv[k_] = *(const u32x4*)(PROJ + (m0 + t0_ + (idx_ >> 3)) * NPROJ + PC_HI + h * 64 + 8 * (idx_ & 7)); } \
        rq = *(const u32x4*)(gq + (t0_ + ((tid_ & 255) >> 1)) * NPROJ); } while (0)
#define HG_STAGE(sb_) do { \
        _Pragma("unroll") for (int k_ = 0; k_ < 2; ++k_) { const int idx_ = tid_ + NTHR * k_; *(LAS u32x4*)(vst + (sb_) * 128 * 64 + (idx_ >> 3) * 64 + 8 * (idx_ & 7)) = rv[k_]; } \
        *(LAS u32x4*)((tid_ < 256 ? qst : fst) + (sb_) * 128 * 16 + ((tid_ & 255) >> 1) * 16 + 8 * (tid_ & 1)) = rq; } while (0)
    unsigned ypend[8] = {0u, 0u, 0u, 0u, 0u, 0u, 0u, 0u};
    HG_FETCH(0);
    HG_STAGE(0);
    LDS_BARRIER();
    for (int sg = 0; sg < SEQ / 128; ++sg) {
        const int sb = sg & 1;
        if (sg + 1 < SEQ / 128) HG_FETCH(sg + 1);
        for (int g4 = 0; g4 < 4; ++g4) {
            const int grp = sg * 4 + g4, buf = grp & 1, r0 = g4 * 32;
            if (w < 4) {
                if (grp > 0) {
#pragma unroll
                    for (int k = 0; k < 8; ++k) OUT[(size_t)((grp - 1) * 32 + 8 * w + k) * opitch] = (bf16)ypend[k];
                }
#pragma unroll
                for (int hh = 0; hh < 2; ++hh) {
                    const int tq = tt + 16 * hh;
                    const float hq = __uint_as_float((unsigned)qst[sb * 128 * 16 + (r0 + tq) * 16 + 4 * w + dd] << 16), fp = __uint_as_float((unsigned)fst[sb * 128 * 16 + (r0 + tq) * 16 + 4 * w + dd] << 16);
                    const float en = __expf(-fabsf(fp)), rd = __builtin_amdgcn_rcpf(1.0f + en), sg_ = fp >= 0.f ? rd : en * rd;
                    LAS float* cr = coef + tq * 8 + dd;
                    cr[0] = lb + (1.0f - lb) * sg_; cr[4] = silu(hq); }
                float pacc[32];
#pragma unroll
                for (int hs = 0; hs < 4; ++hs) {
                    unsigned vraw[8];
#pragma unroll
                    for (int s = 0; s < 8; ++s) vraw[s] = vst[sb * 128 * 64 + (r0 + 8 * hs + s) * 64 + lane];
                    f32x4 cf[8], cq[8];
#pragma unroll
                    for (int s = 0; s < 8; ++s) { const LAS f32x4* cs = (const LAS f32x4*)(coef + (8 * hs + s) * 8); cf[s] = cs[0]; cq[s] = cs[1]; }
#pragma unroll
                    for (int s = 0; s < 8; ++s) {
                        const float vv = __uint_as_float(vraw[s] << 16); const f32x2 v2 = (f32x2){vv, vv};
                        S2[0] = (S2[0] - v2) * (f32x2){cf[s].x, cf[s].y} + v2; S2[1] = (S2[1] - v2) * (f32x2){cf[s].z, cf[s].w} + v2;
                        const f32x2 p2 = (f32x2){cq[s].x, cq[s].y} * S2[0] + (f32x2){cq[s].z, cq[s].w} * S2[1];
                        pacc[8 * hs + s] = p2.x + p2.y;
                    }
                }
#pragma unroll
                for (int s = 0; s < 32; ++s) part[((buf * 4 + w) * 32 + s) * 64 + lane] = pacc[s];
            }
            LDS_BARRIER();
            if (w < 4) {
#pragma unroll
                for (int k = 0; k < 8; ++k) { const int s = 8 * w + k; float o = 0.f;
#pragma unroll
                    for (int ww = 0; ww < 4; ++ww) o += part[((buf * 4 + ww) * 32 + s) * 64 + lane];
                    ypend[k] = f2bf(o); }
            }
        }
        if (sg + 1 < SEQ / 128) { HG_STAGE(sb ^ 1); LDS_BARRIER(); }
    }
    if (w < 4) {
#pragma unroll
        for (int k = 0; k < 8; ++k) OUT[(size_t)((SEQ / 32 - 1) * 32 + 8 * w + k) * opitch] = (bf16)ypend[k];
    }
#undef HG_STAGE
#undef HG_FETCH
}

__device__ __forceinline__ void sb_tile_wave(const Params& p, int l, int task, int lane) {
    const bf16* PROJ = (const bf16*)(p.ws + WS_PROJ); const bf16* VT = (const bf16*)(p.ws + WS_VT); bf16* O = (bf16*)(p.ws + WS_H);
    const int bh = task >> 7, qt = task & 127, b = bh >> 2, h = bh & 3, t0 = qt * 16, g = lane >> 4, c = lane & 15;
    const size_t mb = (size_t)b * SEQ;
    bf16x8_t qfrag[2];
#pragma unroll
    for (int ks = 0; ks < 2; ++ks) qfrag[ks] = *(const bf16x8_t*)(PROJ + (mb + t0 + c) * NPROJ + PC_SBQ + h * 64 + 32 * ks + 8 * g);
    f32x4 oacc[4];
#pragma unroll
    for (int dt = 0; dt < 4; ++dt) oacc[dt] = (f32x4){0.f, 0.f, 0.f, 0.f};
    float carry = 0.f;
    const int tq = t0 + c;
    for (int kb = (t0 + 14) >> 5; kb >= 0; --kb) {
        const int k0 = 32 * kb;
        float w[2][4];
#pragma unroll
        for (int jj = 0; jj < 2; ++jj) {
            const int j = 1 - jj;
            f32x4 acc = (f32x4){0.f, 0.f, 0.f, 0.f};
#pragma unroll
            for (int ks = 0; ks < 2; ++ks) { const bf16x8_t kf = *(const bf16x8_t*)(PROJ + (mb + k0 + 16 * j + c) * NPROJ + PC_SBK + h * 64 + 32 * ks + 8 * g);
                acc = __builtin_amdgcn_mfma_f32_16x16x32_bf16(kf, qfrag[ks], acc, 0, 0, 0); }
            float lk[4], ls[4]; bool valid[4];
#pragma unroll
            for (int i = 0; i < 4; ++i) { const float z = acc[i] * 0.125f; valid[i] = (k0 + 16 * j + 4 * g + i) < tq;
                const float sp = fmaxf(z, 0.f) + __logf(1.0f + __expf(-fabsf(z))); lk[i] = valid[i] ? -sp : 0.f; ls[i] = z - sp; }
            const float suf2 = lk[3], suf1 = lk[3] + lk[2], suf0 = suf1 + lk[1], T = suf0 + lk[0];
            const float T1 = __shfl_down(T, 16), T2 = __shfl_down(T, 32), T3 = __shfl_down(T, 48);
            const float E = (g < 3 ? T1 : 0.f) + (g < 2 ? T2 : 0.f) + (g < 1 ? T3 : 0.f);
            const float Ttot = __shfl(T + E, c);
            const float base = carry + E;
            w[j][0] = valid[0] ? __expf(ls[0] + base + suf0) : 0.f; w[j][1] = valid[1] ? __expf(ls[1] + base + suf1) : 0.f;
            w[j][2] = valid[2] ? __expf(ls[2] + base + suf2) : 0.f; w[j][3] = valid[3] ? __expf(ls[3] + base) : 0.f;
            carry += Ttot;
        }
        u32x4 pu; pu.x = pk2(w[0][0], w[0][1]); pu.y = pk2(w[0][2], w[0][3]); pu.z = pk2(w[1][0], w[1][1]); pu.w = pk2(w[1][2], w[1][3]);
        const bf16x8_t pfrag = __builtin_bit_cast(bf16x8_t, pu);
#pragma unroll
        for (int dt = 0; dt < 4; ++dt) { const bf16* vr = VT + ((size_t)bh * 64 + 16 * dt + c) * SEQ + k0 + 4 * g;
            const u32x2 v0 = *(const u32x2*)vr, v1 = *(const u32x2*)(vr + 16);
            u32x4 vu; vu.x = v0.x; vu.y = v0.y; vu.z = v1.x; vu.w = v1.y;
            oacc[dt] = __builtin_amdgcn_mfma_f32_16x16x32_bf16(__builtin_bit_cast(bf16x8_t, vu), pfrag, oacc[dt], 0, 0, 0); }
        if (__all(carry < -90.0f)) break;
    }
    float ss = 0.f;
#pragma unroll
    for (int dt = 0; dt < 4; ++dt) ss += (oacc[dt][0] * oacc[dt][0] + oacc[dt][1] * oacc[dt][1]) + (oacc[dt][2] * oacc[dt][2] + oacc[dt][3] * oacc[dt][3]);
    ss += __shfl_xor(ss, 16); ss += __shfl_xor(ss, 32);
    const float r = __builtin_amdgcn_rsqf(ss * (1.0f / 64.0f) + EPS);
#pragma unroll
    for (int dt = 0; dt < 4; ++dt) { const f32x4 gn = *(const f32x4*)(p.in[10] + l * 64 + 16 * dt + 4 * g);
        u32x2 o; o.x = pk2(oacc[dt][0] * r * gn.x, oacc[dt][1] * r * gn.y); o.y = pk2(oacc[dt][2] * r * gn.z, oacc[dt][3] * r * gn.w);
        *(u32x2*)(O + (mb + tq) * D + h * 64 + 16 * dt + 4 * g) = o; }
}

__device__ __forceinline__ void phase_scan(const Params& p, int l, LAS unsigned char* lds) {
    if (blockIdx.x < 64) { gdn_scan_block<false>(p, l, blockIdx.x, lds);
#if PROBE == 4
        gdn_scan_block<true>(p, l, blockIdx.x, lds);
#endif
    } else if (blockIdx.x < 192) { hgrn_scan_block(p, l, blockIdx.x - 64, lds);
#if PROBE == 5
        LDS_BARRIER(); hgrn_scan_block(p, l, blockIdx.x - 64, lds);
#endif
    }
    const int tid_ = tid_l(); const int lane = tid_ & 63;
    unsigned* ctr = (unsigned*)(p.ws + WS_TASK) + 64 * l;
    for (;;) {
        unsigned t = 0u;
        if (lane == 0) t = __hip_atomic_fetch_add(ctr, 1u, __ATOMIC_RELAXED, __HIP_MEMORY_SCOPE_AGENT);
        const int task = __builtin_amdgcn_readfirstlane((int)t);
        if (task >= 4096) break;
        sb_tile_wave(p, l, task, lane);
#if PROBE == 6
        sb_tile_wave(p, l, task, lane);
#endif
    }
}

__device__ __forceinline__ void phase_post(const Params& p, int l) {
    const int tid_ = tid_l(); const int wave = __builtin_amdgcn_readfirstlane(tid_ >> 6), lane = tid_ & 63;
    const int gw = blockIdx.x * NWAVES + wave, NGW = gridDim.x * NWAVES;
    const bf16* PROJ = (const bf16*)(p.ws + WS_PROJ); const bf16* P1 = (const bf16*)(p.ws + WS_OMIX); const bf16* Uraw = (const bf16*)(p.ws + WS_U); bf16* O = (bf16*)(p.ws + WS_H);
    const f32x2 gg = *(const f32x2*)(p.in[11] + l * 128 + 2 * lane);
    const f32x4 hg = *(const f32x4*)(p.in[12] + l * 64 + ((4 * lane) & 63));
    for (int mb_ = gw; mb_ < M; mb_ += 2 * NGW) {
        unsigned uo[2][4], uz[2][4]; u32x2 a0[2], a1[2], a2[2], a3[2], ug[2];
#pragma unroll
        for (int t = 0; t < 2; ++t) { const int m = mb_ + t * NGW; if (m < M) {
#pragma unroll
            for (int h = 0; h < 4; ++h) { uo[t][h] = *(const unsigned*)(Uraw + (size_t)m * 512 + h * 128 + 2 * lane); uz[t][h] = *(const unsigned*)(PROJ + (size_t)m * NPROJ + PC_GZ + h * 128 + 2 * lane); }
            a0[t] = *(const u32x2*)(O + (size_t)m * D + 768 + 4 * lane); a1[t] = *(const u32x2*)(P1 + (size_t)m * 256 + 4 * lane); a2[t] = *(const u32x2*)(P1 + ((size_t)M + m) * 256 + 4 * lane);
            a3[t] = *(const u32x2*)((const bf16*)(p.ws + WS_P3) + (size_t)m * 256 + 4 * lane); ug[t] = *(const u32x2*)(PROJ + (size_t)m * NPROJ + PC_HG + 4 * lane); } }
#pragma unroll
        for (int t = 0; t < 2; ++t) { const int m = mb_ + t * NGW; if (m < M) {
#pragma unroll
            for (int h = 0; h < 4; ++h) { const float o0 = bflo(uo[t][h]), o1 = bfhi(uo[t][h]);
                const float r = __builtin_amdgcn_rsqf(wave_sum_fast(o0 * o0 + o1 * o1) * (1.0f / 128.0f) + EPS);
                *(unsigned*)(O + (size_t)m * D + 256 + h * 128 + 2 * lane) = pk2(o0 * r * gg.x * silu(bflo(uz[t][h])), o1 * r * gg.y * silu(bfhi(uz[t][h]))); }
            const float x0 = (bflo(a0[t].x) + bflo(a1[t].x)) + (bflo(a2[t].x) + bflo(a3[t].x)), x1 = (bfhi(a0[t].x) + bfhi(a1[t].x)) + (bfhi(a2[t].x) + bfhi(a3[t].x));
            const float x2 = (bflo(a0[t].y) + bflo(a1[t].y)) + (bflo(a2[t].y) + bflo(a3[t].y)), x3 = (bfhi(a0[t].y) + bfhi(a1[t].y)) + (bfhi(a2[t].y) + bfhi(a3[t].y));
            float ss = (x0 * x0 + x1 * x1) + (x2 * x2 + x3 * x3);
            ss += dpp_mov<0xB1>(ss); ss += dpp_mov<0x4E>(ss); ss += dpp_mov<0x141>(ss); ss += dpp_mov<0x140>(ss);
            const float r = __builtin_amdgcn_rsqf(ss * (1.0f / 64.0f) + EPS);
            u32x2 wv; wv.x = pk2(x0 * r * hg.x * silu(bflo(ug[t].x)), x1 * r * hg.y * silu(bfhi(ug[t].x))); wv.y = pk2(x2 * r * hg.z * silu(bflo(ug[t].y)), x3 * r * hg.w * silu(bfhi(ug[t].y)));
            *(u32x2*)(O + (size_t)m * D + 768 + 4 * lane) = wv; } }
    }
}

#define RLX_AGENT __ATOMIC_RELAXED, __HIP_MEMORY_SCOPE_AGENT
#define XB_TMO      128
#define XB_XCNT(j)  (256  + 64 * (j))
#define XB_XSUB(j)  (1280 + 64 * (j))
#define XB_XGEN(j)  (2304 + 64 * (j))
#define XB_TOP      3328
#define XB_TOPGEN   3392
#define XCD_BAR_WORDS 3456
#define XB_SPIN_CAP (1u << 18)

__device__ __forceinline__ unsigned xb_ld(unsigned* p)              { return __hip_atomic_load(p, __ATOMIC_RELAXED, __HIP_MEMORY_SCOPE_AGENT); }
__device__ __forceinline__ unsigned xb_add(unsigned* p, unsigned v) { return __hip_atomic_fetch_add(p, v, __ATOMIC_RELAXED, __HIP_MEMORY_SCOPE_AGENT); }
__device__ __forceinline__ unsigned xb_xcc_id() { return (unsigned)__builtin_amdgcn_s_getreg((3 << 11) | 20) & 0xFu; }
#define XB_SPIN(cond, bar) do { unsigned _sp = 0; while (cond) { __builtin_amdgcn_s_sleep(1); \
    if ((++_sp & 255u) == 0u) { if (xb_ld(&(bar)[XB_TMO])) break; if (_sp > XB_SPIN_CAP) { atomicAdd(&(bar)[XB_TMO], 1u); break; } } } } while (0)

struct XcdBarrier {
    unsigned* bar; unsigned x;
    volatile LAS unsigned* st;
};

__device__ __forceinline__ XcdBarrier xcd_barrier_post(unsigned* bar, volatile LAS unsigned* st) {
    XcdBarrier b; b.bar = bar; b.x = xb_xcc_id(); b.st = st;
    if (threadIdx.x == 0) (void)xb_add(&bar[XB_XCNT(b.x)], 1u);
    return b;
}
__device__ __forceinline__ void xcd_barrier_complete(unsigned* bar, unsigned x, unsigned& nloc, unsigned& nx) {
    const unsigned G = gridDim.x * gridDim.y * gridDim.z;
    unsigned sum, cnt, mine, sp = 0u;
    for (;;) {
        sum = 0u; cnt = 0u; mine = 0u;
#pragma unroll
        for (unsigned j = 0; j < 16; ++j) { const unsigned c = xb_ld(&bar[XB_XCNT(j)]); sum += c; cnt += (c > 0u) ? 1u : 0u; mine = (j == x) ? c : mine; }
        if (sum == G) break;
        __builtin_amdgcn_s_sleep(1);
        if ((++sp & 255u) == 0u) { if (xb_ld(&bar[XB_TMO])) break; if (sp > XB_SPIN_CAP) { atomicAdd(&bar[XB_TMO], 1u); break; } }
    }
    nloc = mine > 0u ? mine : 1u; nx = cnt > 0u ? cnt : 1u;
}

__device__ __forceinline__ void xcd_barrier(const XcdBarrier& b) {
    asm volatile("s_waitcnt vmcnt(0)" ::: "memory");
    __syncthreads();
    if (threadIdx.x == 0) {
        unsigned* bar = b.bar;
        __builtin_amdgcn_s_waitcnt(0);
        unsigned nloc = b.st[0], nx = b.st[1];
        if (nloc == 0u) { xcd_barrier_complete(bar, b.x, nloc, nx); b.st[0] = nloc; b.st[1] = nx; }
        const unsigned old = xb_add(&bar[XB_XSUB(b.x)], 1u);
        const unsigned gen = old / nloc;
        if (old + 1u == (gen + 1u) * nloc) {
            __builtin_amdgcn_fence(__ATOMIC_RELEASE, "agent");
            asm volatile("s_waitcnt vmcnt(0)" ::: "memory");
            const unsigned og = xb_add(&bar[XB_TOP], 1u);
            const unsigned tg = og / nx;
            if (og + 1u == (tg + 1u) * nx) xb_add(&bar[XB_TOPGEN], 1u);
            else XB_SPIN(xb_ld(&bar[XB_TOPGEN]) == tg, bar);
            __builtin_amdgcn_fence(__ATOMIC_ACQUIRE, "agent");
            xb_add(&bar[XB_XGEN(b.x)], 1u);
            asm volatile("s_waitcnt vmcnt(0)" ::: "memory");
        } else {
            XB_SPIN(xb_ld(&bar[XB_XGEN(b.x)]) == gen, bar);
            __builtin_amdgcn_fence(__ATOMIC_ACQUIRE, "agent");
            asm volatile("s_waitcnt vmcnt(0)" ::: "memory");
        }
    }
    __syncthreads();
}

__global__ void __launch_bounds__(NTHR, 2) fwd_megakernel(Params p) {
    extern __shared__ __attribute__((aligned(16))) unsigned char lds_raw[];
    LAS unsigned char* lds = (LAS unsigned char*)lds_raw;
    cg::grid_group grid = cg::this_grid();
#define GRID_SYNC() do { asm volatile("s_waitcnt vmcnt(0) lgkmcnt(0)" ::: "memory"); grid.sync(); __builtin_amdgcn_fence(__ATOMIC_ACQUIRE, "agent"); asm volatile("s_waitcnt vmcnt(0)" ::: "memory"); } while (0)
    unsigned char* ws = p.ws;
    volatile LAS unsigned* bst = (volatile LAS unsigned*)(lds + LDS_BYTES - 16);
    if (threadIdx.x == 0) { bst[0] = 0u; bst[1] = 0u; }
    __syncthreads();
    const XcdBarrier xbar = xcd_barrier_post((unsigned*)(ws + WS_BAR), bst);
#define XSYNC() xcd_barrier(xbar)
    const float* MOD = (const float*)(ws + WS_MOD);
    bf16* H = (bf16*)(ws + WS_H); bf16* ACT = (bf16*)(ws + WS_PROJ); bf16* PROJ = (bf16*)(ws + WS_PROJ);
    float* X = p.out;

    phase_ada(p, lds);
    phase_convert(p, 0, lds);
    GRID_SYNC();
    for (int l = 0; l < 2; ++l) {
        const float* modl = MOD + (size_t)l * 8 * NMODC;
        const float* Xin = (l == 0) ? p.in[0] : X;
        if (l == 1) phase_convert(p, 1, lds);
        phase_norm<false>(Xin, p.in[2] + l * D, modl + 0 * D, modl + 1 * D, H, nullptr, nullptr, lds);
#if PROBE == 9
        phase_norm<false>(Xin, p.in[2] + l * D, modl + 0 * D, modl + 1 * D, H, nullptr, nullptr, lds);
#endif
        XSYNC();
        { pg8::Gemm g{H, (const bf16*)(ws + WS_W1IN), M, 2 * DFF, D}; pg8::StaticOrder S; S.init(M, 2 * DFF, gridDim.x, blockIdx.x);
          pg8::EpiSwiglu E{ACT, DFF}; pg8::gemm_phase<pg8::EpiSwiglu, pg8::StaticOrder, true, true>(lds, g, S, E); }
        XSYNC();
#if PROBE == 7
        { pg8::Gemm g{H, (const bf16*)(ws + WS_W1IN), M, 2 * DFF, D}; pg8::StaticOrder S; S.init(M, 2 * DFF, gridDim.x, blockIdx.x);
          pg8::EpiSwiglu E{ACT, DFF}; pg8::gemm_phase<pg8::EpiSwiglu, pg8::StaticOrder, true, true>(lds, g, S, E); }
        XSYNC();
#endif
        { pg8::Gemm g{ACT, (const bf16*)(ws + WS_W1OUT), M, D, DFF}; pg8::StaticOrder S; S.init(M, D, gridDim.x, blockIdx.x);
          pg8::EpiResid E{Xin, X, modl + 2 * D, NMODC, 0.5f}; pg8::gemm_phase<pg8::EpiResid, pg8::StaticOrder, true, true>(lds, g, S, E); }
        XSYNC();
        phase_norm<true>(X, p.in[5] + l * D, modl + 3 * D, modl + 4 * D, H, p.in[6] + (size_t)l * 1024 * DIN, (float*)(ws + WS_BA), lds);
#if PROBE == 9
        phase_norm<true>(X, p.in[5] + l * D, modl + 3 * D, modl + 4 * D, H, p.in[6] + (size_t)l * 1024 * DIN, (float*)(ws + WS_BA), lds);
#endif
        XSYNC();
        { pg8::Gemm g{H, (const bf16*)(ws + WS_WMI), M, NPROJ, D}; pg8::StaticOrder S; S.init(M, NPROJ, gridDim.x, blockIdx.x);
          pg8::EpiBf16Plain E{PROJ, NPROJ}; pg8::gemm_phase<pg8::EpiBf16Plain, pg8::StaticOrder, true, true>(lds, g, S, E); }
        XSYNC();
#if PROBE == 8
        { pg8::Gemm g{H, (const bf16*)(ws + WS_WMI), M, NPROJ, D}; pg8::StaticOrder S; S.init(M, NPROJ, gridDim.x, blockIdx.x);
          pg8::EpiBf16Plain E{PROJ, NPROJ}; pg8::gemm_phase<pg8::EpiBf16Plain, pg8::StaticOrder, true, true>(lds, g, S, E); }
        XSYNC();
#endif
        phase_prep(p, l, lds);
        XSYNC();
#if PROBE == 2
        phase_prep(p, l, lds);
        XSYNC();
#endif
#if PROBE == 3
        XSYNC(); XSYNC(); XSYNC(); XSYNC(); XSYNC(); XSYNC(); XSYNC(); XSYNC();
#endif
        phase_scan(p, l, lds);
        XSYNC();
#if PROBE == 1
        phase_scan(p, l, lds);
        XSYNC();
#endif
        phase_post(p, l);
        XSYNC();
        { pg8::Gemm g{H, (const bf16*)(ws + WS_WMO), M, D, D}; pg8::StaticOrder S; S.init(M, D, gridDim.x, blockIdx.x);
          pg8::EpiResid E{X, X, modl + 5 * D, NMODC, 1.0f}; pg8::gemm_phase<pg8::EpiResid, pg8::StaticOrder, true, true>(lds, g, S, E); }
        XSYNC();
        phase_norm<false>(X, p.in[15] + l * D, modl + 6 * D, modl + 7 * D, H, nullptr, nullptr, lds);
#if PROBE == 9
        phase_norm<false>(X, p.in[15] + l * D, modl + 6 * D, modl + 7 * D, H, nullptr, nullptr, lds);
#endif
        XSYNC();
        { pg8::Gemm g{H, (const bf16*)(ws + WS_W2IN), M, 2 * DFF, D}; pg8::StaticOrder S; S.init(M, 2 * DFF, gridDim.x, blockIdx.x);
          pg8::EpiSwiglu E{ACT, DFF}; pg8::gemm_phase<pg8::EpiSwiglu, pg8::StaticOrder, true, true>(lds, g, S, E); }
        XSYNC();
        { pg8::Gemm g{ACT, (const bf16*)(ws + WS_W2OUT), M, D, DFF}; pg8::StaticOrder S; S.init(M, D, gridDim.x, blockIdx.x);
          pg8::EpiResid E{X, X, modl + 8 * D, NMODC, 0.5f}; pg8::gemm_phase<pg8::EpiResid, pg8::StaticOrder, true, true>(lds, g, S, E); }
        XSYNC();
    }
    phase_final(X, p.in[20]);
}

extern "C" void kernel_launch(void* const* d_in, const int* in_sizes, int n_in, void* d_out, int out_size, void* d_ws, size_t ws_size, hipStream_t stream) {
    static int grid = 0;
    if (grid == 0) {
        if (n_in != 21 || out_size != M * D || ws_size < WS_END) { fprintf(stderr, "kernel_launch: unexpected shapes: n_in %d out %d ws %zu (need %zu)\n", n_in, out_size, ws_size, (size_t)WS_END); grid = -1; return; }
        int dev = 0, cus = 0, per_cu = 0;
        hipGetDevice(&dev);
        hipDeviceGetAttribute(&cus, hipDeviceAttributeMultiprocessorCount, dev);
        hipFuncSetAttribute((const void*)fwd_megakernel, hipFuncAttributeMaxDynamicSharedMemorySize, LDS_BYTES);
        hipOccupancyMaxActiveBlocksPerMultiprocessor(&per_cu, (const void*)fwd_megakernel, NTHR, LDS_BYTES);
        if (per_cu < 1) { fprintf(stderr, "kernel_launch: occupancy query says %d blocks per CU\n", per_cu); per_cu = 1; }
        grid = cus * 1;
        (void)hipGetLastError();
    }
    if (grid < 0) return;
    hipMemsetAsync((char*)d_ws + WS_MOD, 0, ZERO_BYTES, stream);
    Params p{};
    for (int i = 0; i < 21; ++i) p.in[i] = (const float*)d_in[i];
    p.out = (float*)d_out; p.ws = (unsigned char*)d_ws;
    void* args[] = {&p};
    hipError_t e = hipLaunchCooperativeKernel((const void*)fwd_megakernel, dim3(grid), dim3(NTHR), args, LDS_BYTES, stream);
    if (e != hipSuccess) fprintf(stderr, "cooperative launch failed: %s (grid %d)\n", hipGetErrorString(e), grid);
}
```
